# Optimizing an MI355X kernel written in HIP

```python
import math
import jax, jax.numpy as jnp
from jax import lax
import numpy as np

D_MODEL = 1024
BATCH = 8
SEQ = 2048
DEPTH = 2
DEC_BATCH = 128
DEC_SEQ = 8
PAST_LEN = 16384
PAGE_SIZE = 128

D_MIX = D_MODEL
D_CONV = D_MIX // 4
CONV_W = 3
GDN_HEADS = 4
GDN_DK = D_MIX // 8
GDN_DV = D_MIX // 8
D_GDN = GDN_HEADS * GDN_DV
D_GDN_QKV = 2 * GDN_HEADS * GDN_DK + D_GDN
GDN_CONV_W = 4
ML_HEADS = 4
ML_DH = D_MIX // 16
D_ML = ML_HEADS * ML_DH
D_FF = (11 * D_MODEL) // 4
FFN_CONV_W = 3
CHUNK = 64
ALPHA = (2.0 * DEPTH) ** 0.25
BETA = (8.0 * DEPTH) ** -0.25
LN_EPS = 1e-5
NORM_EPS = 1e-6
NEG = -1e30
IN_SIZES = (D_CONV, D_CONV, D_CONV,
            GDN_HEADS * GDN_DK, GDN_HEADS * GDN_DK, D_GDN, D_GDN, GDN_HEADS, GDN_HEADS,
            D_ML, D_ML, D_ML, D_ML, ML_HEADS, ML_HEADS)
D_IN = sum(IN_SIZES)

kernel_name = 'hybrid_conv_gdn_mlstm_deepnorm_step'


def layer_norm(x, g, b):
    xf = x.astype(jnp.float32)
    mu = jnp.mean(xf, -1, keepdims=True)
    var = jnp.mean(jnp.square(xf - mu), -1, keepdims=True)
    return ((xf - mu) * lax.rsqrt(var + LN_EPS) * g.astype(jnp.float32) + b.astype(jnp.float32)).astype(x.dtype)


def l2norm(x):
    return x * lax.rsqrt(jnp.sum(x * x, -1, keepdims=True) + NORM_EPS)


def causal_dwconv(x, buf, w):
    width = w.shape[0]
    T = x.shape[1]
    xp = jnp.concatenate([buf.astype(x.dtype), x], axis=1)
    y = xp[:, 0:T] * w[0]
    for j in range(1, width):
        y = y + xp[:, j:j + T] * w[j]
    return y, xp[:, -(width - 1):]


def pad_time(a, pad, value=0.0):
    return jnp.pad(a, [(0, 0), (0, pad)] + [(0, 0)] * (a.ndim - 2), constant_values=value)


def to_chunks(a, L):
    Bn, T = a.shape[:2]
    a = a.reshape((Bn, T // L, L) + a.shape[2:])
    return jnp.moveaxis(jnp.moveaxis(a, 3, 2), 1, 0)


def from_chunks(o, T):
    n, Bn, H, L, D = o.shape
    return jnp.transpose(o, (1, 0, 3, 2, 4)).reshape(Bn, n * L, H, D)[:, :T]


def gated_delta_chunked(q, k, v, g, beta, s0):
    T = q.shape[1]
    DV = v.shape[-1]
    L = min(CHUNK, T)
    n = -(-T // L)
    pad = n * L - T
    qc, kc, vc, gc, bc = [to_chunks(pad_time(a, pad), L) for a in (q, k, v, g, beta)]
    G = jnp.cumsum(gc, axis=-1)
    causal = jnp.tril(jnp.ones((L, L), bool))
    strict = jnp.tril(jnp.ones((L, L), bool), -1)
    decay = jnp.exp(jnp.where(causal, G[..., :, None] - G[..., None, :], -jnp.inf))
    kb = kc * bc[..., None]
    kk = jnp.einsum('nbhik,nbhjk->nbhij', kb, kc) * decay
    M = jnp.eye(L, dtype=kk.dtype) + jnp.where(strict, kk, 0.0)
    rhs = jnp.concatenate([vc * bc[..., None], kb * jnp.exp(G)[..., None]], axis=-1)
    sol = lax.linalg.triangular_solve(M, rhs, left_side=True, lower=True, unit_diagonal=True)
    w_v, w_k = sol[..., :DV], sol[..., DV:]
    qk = jnp.einsum('nbhik,nbhjk->nbhij', qc, kc) * decay

    def step(S, inp):
        wv_i, wk_i, q_i, k_i, qk_i, G_i = inp
        u = wv_i - jnp.einsum('bhik,bhkv->bhiv', wk_i, S)
        o = (jnp.einsum('bhik,bhkv->bhiv', q_i * jnp.exp(G_i)[..., None], S)
             + jnp.einsum('bhij,bhjv->bhiv', qk_i, u))
        g_last = G_i[..., -1]
        S = (S * jnp.exp(g_last)[..., None, None]
             + jnp.einsum('bhik,bhiv->bhkv', k_i * jnp.exp(g_last[..., None] - G_i)[..., None], u))
        return S, o

    S, o = lax.scan(step, s0, (w_v, w_k, qc, kc, qk, G))
    return from_chunks(o, T), S


def mlstm_chunked(q, k, v, ig, lf, c0, n0, m0):
    T = q.shape[1]
    L = min(CHUNK, T)
    n = -(-T // L)
    pad = n * L - T
    qc, kc, vc, fc = [to_chunks(pad_time(a, pad), L) for a in (q, k, v, lf)]
    ic = to_chunks(pad_time(ig, pad, NEG), L)
    F = jnp.cumsum(fc, axis=-1)
    causal = jnp.tril(jnp.ones((L, L), bool))

    def step(carry, inp):
        C, nv, m = carry
        q_i, k_i, v_i, ig_i, F_i = inp
        D = jnp.where(causal, F_i[..., :, None] - F_i[..., None, :] + ig_i[..., None, :], -jnp.inf)
        inter = F_i + m[..., None]
        m_i = jnp.maximum(inter, jnp.max(D, -1))
        wD = jnp.exp(D - m_i[..., None])
        wI = jnp.exp(inter - m_i)
        s = jnp.einsum('bhid,bhjd->bhij', q_i, k_i) * wD
        num = wI[..., None] * jnp.einsum('bhid,bhde->bhie', q_i, C) + jnp.einsum('bhij,bhje->bhie', s, v_i)
        qn = wI * jnp.einsum('bhid,bhd->bhi', q_i, nv) + jnp.sum(s, -1)
        h = num / jnp.maximum(jnp.abs(qn), jnp.exp(-m_i))[..., None]
        m_new = m_i[..., -1]
        wk = jnp.exp(F_i[..., -1:] - F_i + ig_i - m_new[..., None])
        dc = jnp.exp(F_i[..., -1] + m - m_new)
        C = dc[..., None, None] * C + jnp.einsum('bhjd,bhje->bhde', k_i * wk[..., None], v_i)
        nv = dc[..., None] * nv + jnp.einsum('bhjd,bhj->bhd', k_i, wk)
        return (C, nv, m_new), h

    (C, nv, m), h = lax.scan(step, (c0, n0, m0), (qc, kc, vc, ic, F))
    return from_chunks(h, T), C, nv, m


def layer_forward(x, conv_buf, gdn_buf, gdn_s, ml_c, ml_n, ml_m, ffn_buf,
                  w_in, conv_w, gdn_conv_w, gdn_a_log, gdn_dt_bias, gdn_norm_w,
                  ml_i_bias, ml_f_bias, ml_norm_w, w_o, ln1_g, ln1_b,
                  w_up, ffn_conv_w, w_down, ln2_g, ln2_b):
    dt = x.dtype
    f32 = jnp.float32
    Bn, T, _ = x.shape
    proj = jnp.einsum('btd,de->bte', x, w_in)
    idx = np.cumsum(IN_SIZES)[:-1].tolist()
    (a_b, a_c, a_h, g_q, g_k, g_v, g_z, g_a, g_b,
     m_q, m_k, m_v, m_o, m_i, m_f) = jnp.split(proj, idx, axis=-1)
    a_conv, conv_buf_new = causal_dwconv(a_c * a_h, conv_buf, conv_w)
    y_a = (a_b * a_conv).astype(dt)
    qkv, gdn_buf_new = causal_dwconv(jnp.concatenate([g_q, g_k, g_v], -1), gdn_buf, gdn_conv_w)
    qkv = jax.nn.silu(qkv.astype(f32))
    q, k, v = jnp.split(qkv, [GDN_HEADS * GDN_DK, 2 * GDN_HEADS * GDN_DK], axis=-1)
    q = l2norm(q.reshape(Bn, T, GDN_HEADS, GDN_DK)) * (GDN_DK ** -0.5)
    k = l2norm(k.reshape(Bn, T, GDN_HEADS, GDN_DK))
    v = v.reshape(Bn, T, GDN_HEADS, GDN_DV)
    beta = jax.nn.sigmoid(g_b.astype(f32))
    g = -jnp.exp(gdn_a_log.astype(f32)) * jax.nn.softplus(g_a.astype(f32) + gdn_dt_bias.astype(f32))
    o, gdn_s_new = gated_delta_chunked(q, k, v, g, beta, gdn_s.astype(f32))
    o = o * lax.rsqrt(jnp.mean(o * o, -1, keepdims=True) + NORM_EPS) * gdn_norm_w.astype(f32)
    o = o * jax.nn.silu(g_z.astype(f32).reshape(Bn, T, GDN_HEADS, GDN_DV))
    y_b = o.reshape(Bn, T, D_GDN).astype(dt)
    mq = m_q.astype(f32).reshape(Bn, T, ML_HEADS, ML_DH)
    mk = m_k.astype(f32).reshape(Bn, T, ML_HEADS, ML_DH) * (ML_DH ** -0.5)
    mv = m_v.astype(f32).reshape(Bn, T, ML_HEADS, ML_DH)
    ig = m_i.astype(f32) + ml_i_bias.astype(f32)
    lf = jax.nn.log_sigmoid(m_f.astype(f32) + ml_f_bias.astype(f32))
    h, ml_c_new, ml_n_new, ml_m_new = mlstm_chunked(mq, mk, mv, ig, lf, ml_c.astype(f32),
                                                     ml_n.astype(f32), ml_m.astype(f32))
    h = jax.nn.sigmoid(m_o.astype(f32)).reshape(Bn, T, ML_HEADS, ML_DH) * h
    mu = jnp.mean(h, -1, keepdims=True)
    var = jnp.mean(jnp.square(h - mu), -1, keepdims=True)
    h = (h - mu) * lax.rsqrt(var + LN_EPS) * ml_norm_w.astype(f32).reshape(ML_HEADS, ML_DH)
    y_c = h.reshape(Bn, T, D_ML).astype(dt)
    mix = jnp.einsum('bte,ed->btd', jnp.concatenate([y_a, y_b, y_c], -1), w_o)
    x = layer_norm(ALPHA * x + mix, ln1_g, ln1_b)
    up = jnp.einsum('btd,df->btf', x, w_up)
    f_gate, f_val = jnp.split(up, 2, axis=-1)
    f_gate, ffn_buf_new = causal_dwconv(f_gate, ffn_buf, ffn_conv_w)
    ffn = jnp.einsum('btf,fd->btd', jax.nn.silu(f_gate) * f_val, w_down)
    x = layer_norm(ALPHA * x + ffn, ln2_g, ln2_b)
    return (x, conv_buf_new.astype(dt), gdn_buf_new.astype(dt), gdn_s_new.astype(dt),
            ml_c_new.astype(dt), ml_n_new.astype(dt), ml_m_new.astype(dt), ffn_buf_new.astype(dt))


def run_trunk(x, conv_buf, gdn_buf, gdn_s, ml_c, ml_n, ml_m, ffn_buf, weights):
    new = []
    for l in range(DEPTH):
        x, *st = layer_forward(x, conv_buf[l], gdn_buf[l], gdn_s[l], ml_c[l], ml_n[l], ml_m[l], ffn_buf[l],
                               *[w[l] for w in weights])
        new.append(st)
    return x, [jnp.stack([s[i] for s in new]) for i in range(len(new[0]))]


def setup_inputs(seed: int = 0) -> dict:
    key = jax.random.key(seed)
    ks = jax.random.split(key, 32)
    f32 = jnp.float32

    def nrm(k, shape, s):
        return jax.random.normal(k, shape, f32) * s

    dtv = jnp.exp(jax.random.uniform(ks[13], (DEPTH, GDN_HEADS), f32, math.log(1e-3), math.log(1e-1)))
    return {
        'x_prompt': nrm(ks[0], (BATCH, SEQ, D_MODEL), 1.0),
        'x_sample': nrm(ks[1], (DEC_BATCH, DEC_SEQ, D_MODEL), 1.0),
        'state_conv_mix': nrm(ks[2], (DEPTH, DEC_BATCH, CONV_W - 1, D_CONV), 1.0),
        'state_gdn_conv': nrm(ks[3], (DEPTH, DEC_BATCH, GDN_CONV_W - 1, D_GDN_QKV), 1.0),
        'state_gdn': nrm(ks[4], (DEPTH, DEC_BATCH, GDN_HEADS, GDN_DK, GDN_DV), 0.1),
        'state_mlstm_c': nrm(ks[5], (DEPTH, DEC_BATCH, ML_HEADS, ML_DH, ML_DH), 0.1),
        'state_mlstm_n': nrm(ks[6], (DEPTH, DEC_BATCH, ML_HEADS, ML_DH), 0.1),
        'state_mlstm_m': jax.random.uniform(ks[7], (DEPTH, DEC_BATCH, ML_HEADS), f32, 0.0, 4.0),
        'state_ffn_conv': nrm(ks[8], (DEPTH, DEC_BATCH, FFN_CONV_W - 1, D_FF), 1.0),
        'w_in': nrm(ks[9], (DEPTH, D_MODEL, D_IN), D_MODEL ** -0.5),
        'conv_w': nrm(ks[10], (DEPTH, CONV_W, D_CONV), CONV_W ** -0.5),
        'gdn_conv_w': nrm(ks[11], (DEPTH, GDN_CONV_W, D_GDN_QKV), GDN_CONV_W ** -0.5),
        'gdn_a_log': jnp.log(jax.random.uniform(ks[12], (DEPTH, GDN_HEADS), f32, 1.0, 16.0)),
        'gdn_dt_bias': dtv + jnp.log(-jnp.expm1(-dtv)),
        'gdn_norm_w': 1.0 + nrm(ks[14], (DEPTH, GDN_DV), 0.02),
        'ml_i_bias': nrm(ks[15], (DEPTH, ML_HEADS), 0.1),
        'ml_f_bias': jax.random.uniform(ks[16], (DEPTH, ML_HEADS), f32, 3.0, 6.0),
        'ml_norm_w': 1.0 + nrm(ks[17], (DEPTH, D_ML), 0.02),
        'w_o': nrm(ks[18], (DEPTH, D_MIX, D_MODEL), (D_MIX ** -0.5) * BETA),
        'ln1_g': 1.0 + nrm(ks[19], (DEPTH, D_MODEL), 0.02),
        'ln1_b': nrm(ks[20], (DEPTH, D_MODEL), 0.02),
        'w_up': nrm(ks[21], (DEPTH, D_MODEL, 2 * D_FF), D_MODEL ** -0.5),
        'ffn_conv_w': nrm(ks[22], (DEPTH, FFN_CONV_W, D_FF), FFN_CONV_W ** -0.5),
        'w_down': nrm(ks[23], (DEPTH, D_FF, D_MODEL), (D_FF ** -0.5) * BETA),
        'ln2_g': 1.0 + nrm(ks[24], (DEPTH, D_MODEL), 0.02),
        'ln2_b': nrm(ks[25], (DEPTH, D_MODEL), 0.02),
    }


def reference(x_prompt, x_sample, state_conv_mix, state_gdn_conv, state_gdn, state_mlstm_c,
              state_mlstm_n, state_mlstm_m, state_ffn_conv,
              w_in, conv_w, gdn_conv_w, gdn_a_log, gdn_dt_bias, gdn_norm_w,
              ml_i_bias, ml_f_bias, ml_norm_w, w_o, ln1_g, ln1_b,
              w_up, ffn_conv_w, w_down, ln2_g, ln2_b):
    weights = (w_in, conv_w, gdn_conv_w, gdn_a_log, gdn_dt_bias, gdn_norm_w,
               ml_i_bias, ml_f_bias, ml_norm_w, w_o, ln1_g, ln1_b,
               w_up, ffn_conv_w, w_down, ln2_g, ln2_b)
    Bp = x_prompt.shape[0]
    dtp = x_prompt.dtype
    y_prompt, (p_conv, p_gconv, p_gdn, p_c, p_n, p_m, p_ffn) = run_trunk(
        x_prompt,
        jnp.zeros((DEPTH, Bp, CONV_W - 1, D_CONV), dtp),
        jnp.zeros((DEPTH, Bp, GDN_CONV_W - 1, D_GDN_QKV), dtp),
        jnp.zeros((DEPTH, Bp, GDN_HEADS, GDN_DK, GDN_DV), dtp),
        jnp.zeros((DEPTH, Bp, ML_HEADS, ML_DH, ML_DH), dtp),
        jnp.zeros((DEPTH, Bp, ML_HEADS, ML_DH), dtp),
        jnp.zeros((DEPTH, Bp, ML_HEADS), dtp),
        jnp.zeros((DEPTH, Bp, FFN_CONV_W - 1, D_FF), dtp),
        weights)
    y_sample, (s_conv, s_gconv, s_gdn, s_c, s_n, s_m, s_ffn) = run_trunk(
        x_sample, state_conv_mix, state_gdn_conv, state_gdn, state_mlstm_c, state_mlstm_n,
        state_mlstm_m, state_ffn_conv, weights)
    return (y_prompt, y_sample, p_conv, p_gconv, p_gdn, p_c, p_n, p_m, p_ffn,
            s_conv, s_gconv, s_gdn, s_c, s_n, s_m, s_ffn)
```

```cpp
#include <hip/hip_runtime.h>
#include <hip/hip_cooperative_groups.h>
#include <cstdio>
#include <cstdint>
namespace cg = cooperative_groups;

typedef unsigned short bf16_t;
using bf16x8 = __attribute__((ext_vector_type(8))) short;
using f32x4  = __attribute__((ext_vector_type(4))) float;
using u32x4  = __attribute__((ext_vector_type(4))) unsigned;

#define NTOK   17408
#define NPR    16384
#define DM     1024
#define DIN    3856
#define DINS   4096
#define DINP   3968
#define DFF    2816
#define DUP    5632
#define ALPHA_F 1.4142135623730951f

#define O_Y      0ull
#define O_PCONV  (O_Y + 17825792ull)
#define O_PGCONV (O_PCONV + 8192ull)
#define O_PGDN   (O_PGCONV + 73728ull)
#define O_PC     (O_PGDN + 1048576ull)
#define O_PN     (O_PC + 262144ull)
#define O_PM     (O_PN + 4096ull)
#define O_PFFN   (O_PM + 64ull)
#define O_SCONV  (O_PFFN + 90112ull)
#define O_SGCONV (O_SCONV + 131072ull)
#define O_SGDN   (O_SGCONV + 1179648ull)
#define O_SC     (O_SGDN + 16777216ull)
#define O_SN     (O_SC + 4194304ull)
#define O_SM     (O_SN + 65536ull)
#define O_SFFN   (O_SM + 1024ull)

#define WS_WIN   0ull
#define WS_WO    (WS_WIN + 3968ull * 1024 * 2)
#define WS_WUP   (WS_WO + 1024ull * 1024 * 2)
#define WS_WDN   (WS_WUP + 5632ull * 1024 * 2)
#define WS_XB    (WS_WDN + 1024ull * 2816 * 2)
#define WS_C     (WS_XB + (unsigned long long)NTOK * 1024 * 2)
#define WS_PROJ  WS_C
#define WS_QKV   (WS_C + (unsigned long long)NTOK * DINS * 2)
#define QPART    ((size_t)NTOK * 512)
#define WS_UP    WS_C
#define WS_H     WS_C
#define WS_SB    (WS_C + (unsigned long long)NTOK * DFF * 2)
#define WS_GATES (WS_C + (unsigned long long)NTOK * DUP * 2)
#define WS_BAR   (WS_GATES + (unsigned long long)NTOK * 16 * 4)
#define WS_EL    (WS_BAR + 16384ull)
#define WS_END   (WS_EL + 4096ull)

#define DYN_LDS (69632 + 16)
#define LAS __attribute__((address_space(3)))

struct Params {
  const float* in[26];
  float* out;
  char* ws;
};

__device__ __forceinline__ float bf2f(unsigned b) { return __uint_as_float(b << 16); }
typedef __bf16 bf16v2 __attribute__((ext_vector_type(2)));
typedef float f32v2 __attribute__((ext_vector_type(2)));
__device__ __forceinline__ unsigned pack2(float a, float b) {
  f32v2 v = {a, b};
  return __builtin_bit_cast(unsigned, __builtin_convertvector(v, bf16v2));
}
__device__ __forceinline__ unsigned f2bf(float f) { return pack2(f, 0.f) & 0xffffu; }
__device__ __forceinline__ float4 ldnt4(const float* p) {
  const f32x4 v = __builtin_nontemporal_load((const f32x4*)p);
  return make_float4(v[0], v[1], v[2], v[3]);
}
__device__ __forceinline__ void stnt4(float* p, float4 v) {
  __builtin_nontemporal_store((f32x4){v.x, v.y, v.z, v.w}, (f32x4*)p);
}
__device__ __forceinline__ float lo16(unsigned u) { return __uint_as_float(u << 16); }
__device__ __forceinline__ float hi16(unsigned u) { return __uint_as_float(u & 0xffff0000u); }
__device__ __forceinline__ float wsum(float v) {
#pragma unroll
  for (int o = 32; o >= 1; o >>= 1) v += __shfl_xor(v, o);
  return v;
}
__device__ __forceinline__ float sigmoidf_(float x) { return 1.f / (1.f + __expf(-x)); }
__device__ __forceinline__ float siluf_(float x) { return x / (1.f + __expf(-x)); }
__device__ __forceinline__ float softplusf_(float x) { return x > 20.f ? x : log1pf(__expf(x)); }

__device__ __forceinline__ int otid() { int t = threadIdx.x; asm volatile("" : "+v"(t)); return t; }
__device__ __forceinline__ int obid() { int b = blockIdx.x; asm volatile("" : "+s"(b)); return b; }
__device__ __forceinline__ int ogdim() { int b = gridDim.x; asm volatile("" : "+s"(b)); return b; }

__device__ __forceinline__ float wsum_dpp(float v) {
  v += __int_as_float(__builtin_amdgcn_update_dpp(0, __float_as_int(v), 0xB1, 0xf, 0xf, false));
  v += __int_as_float(__builtin_amdgcn_update_dpp(0, __float_as_int(v), 0x4E, 0xf, 0xf, false));
  v += __int_as_float(__builtin_amdgcn_update_dpp(0, __float_as_int(v), 0x141, 0xf, 0xf, false));
  v += __int_as_float(__builtin_amdgcn_update_dpp(0, __float_as_int(v), 0x140, 0xf, 0xf, false));
  v += __shfl_xor(v, 16); v += __shfl_xor(v, 32);
  return v;
}

struct TokInfo { int smp, seq, t, T, NB; };
__device__ __forceinline__ TokInfo tokinfo(int tok) {
  TokInfo r;
  if (tok < NPR) { r.smp = 0; r.seq = tok >> 11; r.t = tok & 2047; r.T = 2048; r.NB = 8; }
  else { int u = tok - NPR; r.smp = 1; r.seq = u >> 3; r.t = u & 7; r.T = 8; r.NB = 128; }
  return r;
}

__device__ void convert_weights(const Params& p, int l, char* smem) {
  float (*tile)[65] = (float (*)[65])smem;
  const int tid = otid();
  const int T_IN = 16 * 62, T_O = 16 * 16, T_UP = 16 * 88, T_DN = 44 * 16;
  const int total = T_IN + T_O + T_UP + T_DN;
  for (int ti = obid(); ti < total; ti += ogdim()) {
    const float* src; bf16_t* dst; int K, N, NP, t = ti;
    if (t < T_IN) { src = p.in[9] + (size_t)l * 1024 * DIN; dst = (bf16_t*)(p.ws + WS_WIN); K = 1024; N = DIN; NP = DINP; }
    else if ((t -= T_IN) < T_O) { src = p.in[18] + (size_t)l * 1024 * 1024; dst = (bf16_t*)(p.ws + WS_WO); K = 1024; N = 1024; NP = 1024; }
    else if ((t -= T_O) < T_UP) { src = p.in[21] + (size_t)l * 1024 * DUP; dst = (bf16_t*)(p.ws + WS_WUP); K = 1024; N = DUP; NP = DUP; }
    else { t -= T_UP; src = p.in[23] + (size_t)l * DFF * 1024; dst = (bf16_t*)(p.ws + WS_WDN); K = DFF; N = 1024; NP = 1024; }
    const int tn = NP / 64;
    const int kt = t / tn, nt = t % tn;
#pragma unroll
    for (int ps = 0; ps < 4; ++ps) {
      int r = (tid >> 4) + ps * 16, c = (tid & 15) * 4;
      int n = nt * 64 + c;
      float4 v = make_float4(0.f, 0.f, 0.f, 0.f);
      if (n < N) v = ldnt4(src + (size_t)(kt * 64 + r) * N + n);
      tile[r][c] = v.x; tile[r][c + 1] = v.y; tile[r][c + 2] = v.z; tile[r][c + 3] = v.w;
    }
    __syncthreads();
    {
      int nl = tid >> 2, kq = tid & 3;
      unsigned u[8];
#pragma unroll
      for (int j = 0; j < 8; ++j) u[j] = pack2(tile[kq * 16 + 2 * j][nl], tile[kq * 16 + 2 * j + 1][nl]);
      int nrow = nt * 64 + nl;
      if (N == DUP) {
        const int isv = nrow >= DFF, f = isv ? nrow - DFF : nrow;
        nrow = (f >> 6) * 128 + ((f >> 5) & 1) * 64 + (((f >> 2) & 1) + 2 * isv) * 16 + ((f >> 3) & 3) * 4 + (f & 3);
      }
      uint4* d = (uint4*)(dst + (size_t)nrow * K + kt * 64 + kq * 16);
      d[0] = make_uint4(u[0], u[1], u[2], u[3]);
      d[1] = make_uint4(u[4], u[5], u[6], u[7]);
    }
    __syncthreads();
  }
}

__device__ void convert_x(const Params& p) {
  bf16_t* xb = (bf16_t*)(p.ws + WS_XB);
  const size_t n8 = (size_t)NTOK * 1024 / 8;
  const size_t npr8 = (size_t)NPR * 1024 / 8;
  for (size_t i = (size_t)obid() * 256 + otid(); i < n8; i += (size_t)ogdim() * 256) {
    const float* s = (i < npr8) ? (p.in[0] + i * 8) : (p.in[1] + (i - npr8) * 8);
    float4 a = ldnt4(s), b = ldnt4(s + 4);
    *(uint4*)(xb + i * 8) = make_uint4(pack2(a.x, a.y), pack2(a.z, a.w), pack2(b.x, b.y), pack2(b.z, b.w));
  }
}

#define GBUF 34816
#define LDS_STRIDE 72
template <int MODE>
__device__ void gemm_phase(const Params& p, int l, char* smem) {
  constexpr int K = (MODE == 4) ? DFF : 1024;
  constexpr int NT = (MODE == 1) ? 30 : (MODE == 3) ? 44 : 8;
  constexpr int LDA = (MODE == 1 || MODE == 3) ? 1024 : (MODE == 2) ? DINS : DFF;
  const bf16_t* A = (MODE == 1 || MODE == 3) ? (const bf16_t*)(p.ws + WS_XB)
                  : (MODE == 2) ? (const bf16_t*)(p.ws + WS_PROJ)
                                : (const bf16_t*)(p.ws + WS_H);
  const bf16_t* Bt = (const bf16_t*)(p.ws + ((MODE == 1) ? WS_WIN : (MODE == 2) ? WS_WO : (MODE == 3) ? WS_WUP : WS_WDN));
  bf16_t* sA = (bf16_t*)smem;
  bf16_t* sB = sA + 128 * 64;
  const int tid = otid(), lane = tid & 63, w = tid >> 6, wm = w >> 1, wn = w & 1;
  const int lr = tid >> 3, lc = (tid & 7) * 8;
  const int l15 = lane & 15, l4 = lane >> 4;
  const int wsw = (((tid & 7) ^ ((lr >> 1) & 7)) * 8);
  const int rsw0 = ((l4 ^ ((l15 >> 1) & 7)) * 8), rsw1 = (((l4 + 4) ^ ((l15 >> 1) & 7)) * 8);

  constexpr int PN = (NT + 7) / 8;
  const int bid_ = obid(), gd_ = ogdim();
  const bool swz = (gd_ == 512) && (MODE == 2 || MODE == 4);
  const int nwork = swz ? ((17 * PN + 7) / 8) * 512 : 136 * NT;
  for (int wi = bid_; wi < nwork; wi += gd_) {
    int mt, nt;
    if (swz) {
      const int patch = (wi >> 9) * 8 + (bid_ & 7);
      const int j = bid_ >> 3;
      const int pn = patch / 17, pm = patch % 17;
      mt = pm * 8 + (j >> 3); nt = pn * 8 + (j & 7);
      if (pn >= PN || nt >= NT) continue;
    } else { mt = wi / NT; nt = wi % NT; }
    const int m0 = mt * 128, n0 = nt * 128;
    f32x4 acc[4][4];
#pragma unroll
    for (int i = 0; i < 4; ++i)
#pragma unroll
      for (int j = 0; j < 4; ++j) acc[i][j] = (f32x4){0.f, 0.f, 0.f, 0.f};
    const bool wide = (MODE == 1) && (nt == NT - 1);
    f32x4 accx[4];
#pragma unroll
    for (int i = 0; i < 4; ++i) accx[i] = (f32x4){0.f, 0.f, 0.f, 0.f};
    const bf16_t* ap = A + (size_t)(m0 + lr) * LDA + lc;
    const bf16_t* bp = Bt + (size_t)(n0 + lr) * K + lc;
    constexpr int KT = K / 64;
#define GLDS_TILE(KT_, BUF_)                                                                       \
    {                                                                                              \
      const int k1_ = (KT_) * 64;                                                                  \
      const int acol_ = k1_ + ((MODE == 2 && k1_ >= 256) ? 512 : 0);                               \
      char* da_ = smem + (BUF_) * GBUF + w * 1024;                                                \
      _Pragma("unroll") for (int i = 0; i < 4; ++i) {                                              \
        __builtin_amdgcn_global_load_lds((const unsigned*)(gap + (size_t)i * 32 * LDA + acol_),    \
                                         (LAS unsigned*)(da_ + i * 4096), 16, 0, 0);               \
        __builtin_amdgcn_global_load_lds((const unsigned*)(gbp + (size_t)i * 32 * K + k1_),        \
                                         (LAS unsigned*)(da_ + 16384 + i * 4096), 16, 0, 0);       \
      }                                                                                            \
      if (wide && w < 2)                                                                           \
        __builtin_amdgcn_global_load_lds((const unsigned*)(gbp + (size_t)128 * K + k1_),           \
                                         (LAS unsigned*)(da_ + 32768), 16, 0, 0);                  \
    }
    const int rloc = w * 8 + (lane >> 3);
    const int gch = ((lane & 7) ^ ((rloc >> 1) & 7)) * 8;
    const bf16_t* gap = A + (size_t)(m0 + rloc) * LDA + gch;
    const bf16_t* gbp = Bt + (size_t)(n0 + rloc) * K + gch;
    GLDS_TILE(0, 0)
    for (int kt = 0; kt < KT; ++kt) {
      const int buf = kt & 1;
      asm volatile("s_waitcnt vmcnt(0) lgkmcnt(0)" ::: "memory");
      __builtin_amdgcn_s_barrier();
      asm volatile("" ::: "memory");
      __builtin_amdgcn_s_setprio(2);
      if (kt + 1 < KT) GLDS_TILE(kt + 1, buf ^ 1)
      const bf16_t* cA = (const bf16_t*)(smem + buf * GBUF);
      const bf16_t* cB = cA + 128 * 64;
      bf16x8 af0[4], bf0[4], af1[4], bf1[4];
#pragma unroll
      for (int i = 0; i < 4; ++i) af0[i] = *(const bf16x8*)(cA + (wm * 64 + i * 16 + l15) * 64 + rsw0);
#pragma unroll
      for (int j = 0; j < 4; ++j) bf0[j] = *(const bf16x8*)(cB + (wn * 64 + j * 16 + l15) * 64 + rsw0);
#pragma unroll
      for (int i = 0; i < 4; ++i) af1[i] = *(const bf16x8*)(cA + (wm * 64 + i * 16 + l15) * 64 + rsw1);
#pragma unroll
      for (int j = 0; j < 4; ++j) bf1[j] = *(const bf16x8*)(cB + (wn * 64 + j * 16 + l15) * 64 + rsw1);
      __builtin_amdgcn_s_setprio(0);
      __builtin_amdgcn_sched_barrier(0);
#pragma unroll
      for (int i = 0; i < 4; ++i)
#pragma unroll
        for (int j = 0; j < 4; ++j)
          acc[i][j] = __builtin_amdgcn_mfma_f32_16x16x32_bf16(bf0[j], af0[i], acc[i][j], 0, 0, 0);
#pragma unroll
      for (int i = 0; i < 4; ++i)
#pragma unroll
        for (int j = 0; j < 4; ++j)
          acc[i][j] = __builtin_amdgcn_mfma_f32_16x16x32_bf16(bf1[j], af1[i], acc[i][j], 0, 0, 0);
      if (MODE == 1 && wide && wn == 1) {
        const bf16x8 bx0 = *(const bf16x8*)(cB + (128 + l15) * 64 + rsw0), bx1 = *(const bf16x8*)(cB + (128 + l15) * 64 + rsw1);
#pragma unroll
        for (int i = 0; i < 4; ++i) {
          accx[i] = __builtin_amdgcn_mfma_f32_16x16x32_bf16(bx0, af0[i], accx[i], 0, 0, 0);
          accx[i] = __builtin_amdgcn_mfma_f32_16x16x32_bf16(bx1, af1[i], accx[i], 0, 0, 0);
        }
      }
    }
    asm volatile("s_waitcnt lgkmcnt(0)" ::: "memory");
    __builtin_amdgcn_s_barrier();
    asm volatile("" ::: "memory");
#undef GLDS_TILE
    if (MODE == 3) {
      float* gL = (float*)smem;
#pragma unroll
      for (int i = 0; i < 4; ++i)
#pragma unroll
        for (int j = 0; j < 2; ++j)
          *(float4*)(gL + (wm * 64 + i * 16 + l15) * 68 + wn * 32 + l4 * 8 + j * 4) = make_float4(acc[i][j][0], acc[i][j][1], acc[i][j][2], acc[i][j][3]);
      __syncthreads();
      bf16_t* hb = (bf16_t*)(p.ws + WS_H);
      bf16_t* sb = (bf16_t*)(p.ws + WS_SB) + (size_t)mt * 4 * 2 * DFF;
      const float* cw = p.in[22] + (size_t)l * 3 * DFF;
#pragma unroll
      for (int i = 0; i < 4; ++i) {
        const int row = wm * 64 + i * 16 + l15, m = m0 + row;
        const TokInfo ti = tokinfo(m);
        const bool defer = (row == 0 && ti.t >= 1) || (row == 1 && ti.t >= 2);
        const int slot = (row < 2) ? row : (row >= 126 ? row - 124 : -1);
        uint2 hq[2];
#pragma unroll
        for (int j = 0; j < 2; ++j) {
          const int fl = wn * 32 + l4 * 8 + j * 4, f = nt * 64 + fl;
          const f32x4 g0 = acc[i][j], vv = acc[i][j + 2];
          if (slot >= 0) {
            *(uint2*)(sb + (size_t)(slot * 2) * DFF + f) = make_uint2(pack2(g0[0], g0[1]), pack2(g0[2], g0[3]));
            if (slot < 2) *(uint2*)(sb + (size_t)(slot * 2 + 1) * DFF + f) = make_uint2(pack2(vv[0], vv[1]), pack2(vv[2], vv[3]));
          }
          if (ti.t >= ti.T - 2) {
            float* o = p.out + (ti.smp ? O_SFFN : O_PFFN) + ((size_t)(l * ti.NB + ti.seq) * 2 + (ti.t - (ti.T - 2))) * DFF + f;
            *(float4*)o = make_float4(g0[0], g0[1], g0[2], g0[3]);
          }
          if (!defer) {
            float4 g1 = make_float4(0.f, 0.f, 0.f, 0.f), g2 = make_float4(0.f, 0.f, 0.f, 0.f);
            if (ti.t >= 1) g1 = *(const float4*)(gL + (row - 1) * 68 + fl);
            else if (ti.smp) g1 = *(const float4*)(p.in[8] + ((size_t)(l * 128 + ti.seq) * 2 + 1) * DFF + f);
            if (ti.t >= 2) g2 = *(const float4*)(gL + (row - 2) * 68 + fl);
            else if (ti.smp) g2 = *(const float4*)(p.in[8] + ((size_t)(l * 128 + ti.seq) * 2 + ti.t) * DFF + f);
            const float4 w0 = *(const float4*)(cw + f), w1 = *(const float4*)(cw + DFF + f), w2 = *(const float4*)(cw + 2 * DFF + f);
            const float h0 = siluf_(w0.x * g2.x + w1.x * g1.x + w2.x * g0[0]) * vv[0];
            const float h1 = siluf_(w0.y * g2.y + w1.y * g1.y + w2.y * g0[1]) * vv[1];
            const float h2 = siluf_(w0.z * g2.z + w1.z * g1.z + w2.z * g0[2]) * vv[2];
            const float h3 = siluf_(w0.w * g2.w + w1.w * g1.w + w2.w * g0[3]) * vv[3];
            hq[j] = make_uint2(pack2(h0, h1), pack2(h2, h3));
          }
        }
        if (!defer) *(u32x4*)(hb + (size_t)m * DFF + nt * 64 + wn * 32 + l4 * 8) = (u32x4){hq[0].x, hq[0].y, hq[1].x, hq[1].y};
      }
      __syncthreads();
      continue;
    }
    if (MODE == 1 && wide && wn == 1) {
      bf16_t* proj = (bf16_t*)(p.ws + WS_PROJ);
      float* gates = (float*)(p.ws + WS_GATES);
#pragma unroll
      for (int i = 0; i < 4; ++i) {
        const int m = m0 + wm * 64 + i * 16 + l15, n = n0 + 128 + l4 * 4;
        const f32x4 a = accx[i];
        *(uint2*)(proj + (size_t)m * DINS + n) = make_uint2(pack2(a[0], a[1]), pack2(a[2], a[3]));
        if (n >= 3848) *(float4*)(gates + (size_t)m * 16 + 8 + (n - 3848)) = make_float4(a[0], a[1], a[2], a[3]);
      }
    }
#pragma unroll
    for (int i = 0; i < 4; ++i) {
      const int m = m0 + wm * 64 + i * 16 + l15;
#pragma unroll
      for (int j = 0; j < 4; ++j) {
        const int n = n0 + wn * 64 + j * 16 + l4 * 4;
        f32x4 a = acc[i][j];
        if (MODE == 1) {
          if (n < DIN) {
            bf16_t* proj = (bf16_t*)(p.ws + WS_PROJ);
            *(uint2*)(proj + (size_t)m * DINS + n) = make_uint2(pack2(a[0], a[1]), pack2(a[2], a[3]));
            float* gates = (float*)(p.ws + WS_GATES);
            if (n >= 2816 && n < 2824) *(float4*)(gates + (size_t)m * 16 + (n - 2816)) = make_float4(a[0], a[1], a[2], a[3]);
            if (n >= 3848) *(float4*)(gates + (size_t)m * 16 + 8 + (n - 3848)) = make_float4(a[0], a[1], a[2], a[3]);
          }
        } else if (MODE == 3) {
          bf16_t* up = (bf16_t*)(p.ws + WS_UP);
          *(uint2*)(up + (size_t)m * DUP + n) = make_uint2(pack2(a[0], a[1]), pack2(a[2], a[3]));
          if (n < DFF) {
            TokInfo ti = tokinfo(m);
            if (ti.t >= ti.T - 2) {
              float* o = p.out + (ti.smp ? O_SFFN : O_PFFN) + ((size_t)(l * ti.NB + ti.seq) * 2 + (ti.t - (ti.T - 2))) * DFF + n;
              *(float4*)o = make_float4(a[0], a[1], a[2], a[3]);
            }
          }
        } else {
          const bf16_t* xb = (const bf16_t*)(p.ws + WS_XB);
          uint2 xv = *(const uint2*)(xb + (size_t)m * 1024 + n);
          float4 r;
          r.x = ALPHA_F * lo16(xv.x) + a[0];
          r.y = ALPHA_F * hi16(xv.x) + a[1];
          r.z = ALPHA_F * lo16(xv.y) + a[2];
          r.w = ALPHA_F * hi16(xv.y) + a[3];
          *(float4*)(p.out + O_Y + (size_t)m * 1024 + n) = r;
        }
      }
    }
  }
}

template <int CTRL> __device__ __forceinline__ float dppf1(float v) {
  return __int_as_float(__builtin_amdgcn_update_dpp(0, __float_as_int(v), CTRL, 0xf, 0xf, false));
}
__device__ __forceinline__ float wsum_fast(float v) {
  v += dppf1<0xB1>(v); v += dppf1<0x4E>(v); v += dppf1<0x141>(v); v += dppf1<0x140>(v);
  v += __shfl_xor(v, 16); v += __shfl_xor(v, 32);
  return v;
}
template <int RT, int SMP>
__device__ void e1_run(const Params& p, int l, int seq, int t0) {
  constexpr int T = SMP ? 8 : 2048, NB = SMP ? 128 : 8;
  bf16_t* proj = (bf16_t*)(p.ws + WS_PROJ);
  bf16_t* qkvp = (bf16_t*)(p.ws + WS_QKV);
  float* gates = (float*)(p.ws + WS_GATES);
  const float* conv_w = p.in[10] + l * 3 * 256;
  const float* gconv_w = p.in[11] + l * 4 * 1536;
  const int lane = otid() & 63;
  const int tokbase = SMP ? NPR + seq * 8 : seq * 2048;
  {
    const int ti = lane >> 2, h = lane & 3;
    if (ti < RT) {
      float* g = gates + (size_t)(tokbase + t0 + ti) * 16;
      const float ga = g[h], gb = g[4 + h], mi = g[8 + h], mf = g[12 + h];
      const float gg = -__expf(p.in[12][l * 4 + h]) * softplusf_(ga + p.in[13][l * 4 + h]);
      g[h] = __expf(gg);
      g[4 + h] = sigmoidf_(gb);
      g[8 + h] = mi + p.in[15][l * 4 + h];
      g[12 + h] = -softplusf_(-(mf + p.in[16][l * 4 + h]));
    }
  }
#pragma unroll 1
  for (int hb = 0; hb < RT / 8; ++hb) {
    const int c = lane * 4, th = t0 + hb * 8;
    float ah[10][4];
#pragma unroll
    for (int d = 0; d < 10; ++d) {
      const int tt = th - 2 + d;
      if (tt >= 0) {
        const bf16_t* r = proj + (size_t)(tokbase + tt) * DINS;
        const uint2 uc = *(const uint2*)(r + 256 + c), uh = *(const uint2*)(r + 512 + c);
        ah[d][0] = lo16(uc.x) * lo16(uh.x); ah[d][1] = hi16(uc.x) * hi16(uh.x);
        ah[d][2] = lo16(uc.y) * lo16(uh.y); ah[d][3] = hi16(uc.y) * hi16(uh.y);
      } else if (SMP) {
        const float4 v = *(const float4*)(p.in[2] + ((size_t)(l * 128 + seq) * 2 + (tt + 2)) * 256 + c);
        ah[d][0] = v.x; ah[d][1] = v.y; ah[d][2] = v.z; ah[d][3] = v.w;
      } else { ah[d][0] = ah[d][1] = ah[d][2] = ah[d][3] = 0.f; }
    }
    const float4 w0 = *(const float4*)(conv_w + c), w1 = *(const float4*)(conv_w + 256 + c), w2 = *(const float4*)(conv_w + 512 + c);
#pragma unroll
    for (int j = 0; j < 8; ++j) {
      bf16_t* row = proj + (size_t)(tokbase + th + j) * DINS;
      const uint2 ub = *(const uint2*)(row + c);
      const float y0 = lo16(ub.x) * (w0.x * ah[j][0] + w1.x * ah[j + 1][0] + w2.x * ah[j + 2][0]);
      const float y1 = hi16(ub.x) * (w0.y * ah[j][1] + w1.y * ah[j + 1][1] + w2.y * ah[j + 2][1]);
      const float y2 = lo16(ub.y) * (w0.z * ah[j][2] + w1.z * ah[j + 1][2] + w2.z * ah[j + 2][2]);
      const float y3 = hi16(ub.y) * (w0.w * ah[j][3] + w1.w * ah[j + 1][3] + w2.w * ah[j + 2][3]);
      *(uint2*)(row + c) = make_uint2(pack2(y0, y1), pack2(y2, y3));
      const int t = th + j;
      if (t >= T - 2) {
        float* o = p.out + (SMP ? O_SCONV : O_PCONV) + ((size_t)(l * NB + seq) * 2 + (t - (T - 2))) * 256 + c;
        *(float4*)o = make_float4(ah[j + 2][0], ah[j + 2][1], ah[j + 2][2], ah[j + 2][3]);
      }
    }
  }
  float x0[RT + 3], x1[RT + 3], n0[RT + 3], n1[RT + 3];
  auto segload = [&](int seg, float (&a0)[RT + 3], float (&a1)[RT + 3]) {
    const int ch = seg * 128 + lane * 2;
#pragma unroll
    for (int d = 0; d < RT + 3; ++d) {
      const int tt = t0 - 3 + d;
      if (tt >= 0) {
        const unsigned u = *(const unsigned*)(proj + (size_t)(tokbase + tt) * DINS + 768 + ch);
        a0[d] = lo16(u); a1[d] = hi16(u);
      } else if (SMP) {
        const float2 v = *(const float2*)(p.in[3] + ((size_t)(l * 128 + seq) * 3 + (tt + 3)) * 1536 + ch);
        a0[d] = v.x; a1[d] = v.y;
      } else { a0[d] = 0.f; a1[d] = 0.f; }
    }
  };
  segload(0, x0, x1);
#pragma unroll 1
  for (int seg = 0; seg < 12; ++seg) {
    const int ch = seg * 128 + lane * 2;
    segload(seg < 11 ? seg + 1 : 11, n0, n1);
    float2 wv[4];
#pragma unroll
    for (int d = 0; d < 4; ++d) wv[d] = *(const float2*)(gconv_w + d * 1536 + ch);
#pragma unroll
    for (int j = 0; j < RT; ++j) {
      float c0 = 0.f, c1 = 0.f;
#pragma unroll
      for (int d = 0; d < 4; ++d) { c0 += wv[d].x * x0[j + d]; c1 += wv[d].y * x1[j + d]; }
      float s0 = siluf_(c0), s1 = siluf_(c1);
      if (seg < 8) {
        const float ss = wsum_fast(s0 * s0 + s1 * s1);
        float r = rsqrtf(ss + 1e-6f);
        if (seg < 4) r *= 0.08838834764831845f;
        s0 *= r; s1 *= r;
      }
      const int t = t0 + j;
      *(unsigned*)(qkvp + (size_t)(ch >> 9) * QPART + (size_t)(tokbase + t) * 512 + (ch & 511)) = pack2(s0, s1);
      if (t >= T - 3) {
        float* o = p.out + (SMP ? O_SGCONV : O_PGCONV) + ((size_t)(l * NB + seq) * 3 + (t - (T - 3))) * 1536 + ch;
        *(float2*)o = make_float2(x0[j + 3], x1[j + 3]);
      }
    }
#pragma unroll
    for (int d = 0; d < RT + 3; ++d) { x0[d] = n0[d]; x1[d] = n1[d]; }
  }
}
__device__ void e1_phase(const Params& p, int l) {
  const int gw = obid() * 4 + (otid() >> 6), nw = ogdim() * 4;
  for (int task = gw; task < 1152; task += nw) {
    if (task < 1024) e1_run<16, 0>(p, l, task >> 7, (task & 127) * 16);
    else e1_run<8, 1>(p, l, task - 1024, 0);
  }
}

template <int CTRL> __device__ __forceinline__ float dppf(float v) {
  return __int_as_float(__builtin_amdgcn_update_dpp(0, __float_as_int(v), CTRL, 0xf, 0xf, false));
}
__device__ __forceinline__ float red8(float v) {
  v += dppf<0xB1>(v); v += dppf<0x4E>(v); v += dppf<0x141>(v);
  return v;
}
__device__ __forceinline__ float red16(float v) {
  v += dppf<0xB1>(v); v += dppf<0x4E>(v); v += dppf<0x141>(v); v += dppf<0x140>(v);
  return v;
}

__device__ __forceinline__ float fma_(float a, float b, float c) { float d; asm("v_fma_f32 %0, %1, %2, %3" : "=v"(d) : "v"(a), "v"(b), "v"(c)); return d; }
__device__ __forceinline__ float exp_(float x) { float d; asm("v_exp_f32 %0, %1\n\ts_nop 1" : "=v"(d) : "v"(x * 1.4426950408889634f)); return d; }
__device__ __forceinline__ float mul_(float a, float b) { float d; asm("v_mul_f32 %0, %1, %2" : "=v"(d) : "v"(a), "v"(b)); return d; }
template <int NV>
__device__ void gdn_block(const Params& p, int l, int smp, int id, char* smem) {
  constexpr int NVQ = 8 / NV;
  constexpr int VB = 32 * NV;
  constexpr int BUF = 8192 + 16 * VB + 128;
  const int tid = otid(), lane = tid & 63, w = tid >> 6;
  const int kg = lane & 15, vi = lane >> 4;
  const int vq = id % NVQ, h = (id / NVQ) & 3, seq = id / (NVQ * 4);
  const int vloc = (w * 4 + vi) * NV;
  const int vcol = vq * 16 * NV + vloc;
  const int T = smp ? 8 : 2048, NB = smp ? 128 : 8;
  const int tok0 = smp ? NPR + seq * 8 : seq * 2048;
  const int tlast = tok0 + T - 1;
  const bf16_t* qkvp = (const bf16_t*)(p.ws + WS_QKV);
  bf16_t* proj = (bf16_t*)(p.ws + WS_PROJ);
  const float* gates = (const float*)(p.ws + WS_GATES);
  float S[NV][8];
  if (smp) {
    const float* s0 = p.in[4] + ((size_t)(l * 128 + seq) * 4 + h) * 16384 + (size_t)(kg * 8) * 128 + vcol;
#pragma unroll
    for (int j = 0; j < 8; ++j) {
      if (NV == 8) {
        float4 x = ldnt4(s0 + j * 128), y = ldnt4(s0 + j * 128 + 4);
        S[0][j] = x.x; S[1 % NV][j] = x.y; S[2 % NV][j] = x.z; S[3 % NV][j] = x.w;
        S[4 % NV][j] = y.x; S[5 % NV][j] = y.y; S[6 % NV][j] = y.z; S[7 % NV][j] = y.w;
      } else {
#pragma unroll
        for (int i = 0; i < NV; ++i) S[i][j] = s0[j * 128 + i];
      }
    }
  } else {
#pragma unroll
    for (int i = 0; i < NV; ++i)
#pragma unroll
      for (int j = 0; j < 8; ++j) S[i][j] = 0.f;
  }
  const int ltok = tid >> 4, lpart = tid & 15;
  const int vtok = tid / (2 * NV), vpart = tid % (2 * NV);
  const int gtok = (tid & 31) >> 1, gwhich = tid & 1;
  u32x4 rq, rk, rv = (u32x4){0u, 0u, 0u, 0u}; float rg = 0.f;
  const int nch = (T + 15) >> 4;
  auto gload = [&](int c) {
    int tk = tok0 + c * 16 + ltok; tk = tk > tlast ? tlast : tk;
    const bf16_t* r = qkvp + (size_t)tk * 512 + h * 128 + lpart * 8;
    rq = *(const u32x4*)r; rk = *(const u32x4*)(r + QPART);
    if (tid < 32 * NV) {
      int tv = tok0 + c * 16 + vtok; tv = tv > tlast ? tlast : tv;
      rv = *(const u32x4*)(qkvp + 2 * QPART + (size_t)tv * 512 + h * 128 + vq * 16 * NV + vpart * 8);
    }
    if (tid < 32) {
      int tg = tok0 + c * 16 + gtok; tg = tg > tlast ? tlast : tg;
      rg = gates[(size_t)tg * 16 + gwhich * 4 + h];
    }
  };
  auto lstore = [&](int b) {
    char* B = smem + b * BUF;
    *(u32x4*)(B + ltok * 256 + lpart * 16) = rq;
    *(u32x4*)(B + 4096 + ltok * 256 + lpart * 16) = rk;
    if (tid < 32 * NV) *(u32x4*)(B + 8192 + vtok * VB + vpart * 16) = rv;
    if (tid < 32) *(float*)(B + 8192 + 16 * VB + gtok * 8 + gwhich * 4) = rg;
  };
  __syncthreads();
  gload(0);
  lstore(0);
  __syncthreads();
  for (int c = 0; c < nch; ++c) {
    if (c + 1 < nch) gload(c + 1);
    const char* B = smem + (c & 1) * BUF;
    const int nt = (T - c * 16) < 16 ? (T - c * 16) : 16;
#pragma unroll 4
    for (int t = 0; t < nt; ++t) {
      const u32x4 cq = *(const u32x4*)(B + t * 256 + kg * 16), ck = *(const u32x4*)(B + 4096 + t * 256 + kg * 16);
      const float2 cab = *(const float2*)(B + 8192 + 16 * VB + t * 8);
      float vv[NV];
      if (NV == 8) {
        const u32x4 cv = *(const u32x4*)(B + 8192 + t * VB + vloc * 2);
        vv[0] = lo16(cv[0]); vv[1 % NV] = hi16(cv[0]); vv[2 % NV] = lo16(cv[1]); vv[3 % NV] = hi16(cv[1]);
        vv[4 % NV] = lo16(cv[2]); vv[5 % NV] = hi16(cv[2]); vv[6 % NV] = lo16(cv[3]); vv[7 % NV] = hi16(cv[3]);
      } else {
#pragma unroll
        for (int i = 0; i < NV; ++i) vv[i] = bf2f(*(const unsigned short*)(B + 8192 + t * VB + (vloc + i) * 2));
      }
      float kk[8], qq[8];
      kk[0] = lo16(ck[0]); kk[1] = hi16(ck[0]); kk[2] = lo16(ck[1]); kk[3] = hi16(ck[1]);
      kk[4] = lo16(ck[2]); kk[5] = hi16(ck[2]); kk[6] = lo16(ck[3]); kk[7] = hi16(ck[3]);
      qq[0] = lo16(cq[0]); qq[1] = hi16(cq[0]); qq[2] = lo16(cq[1]); qq[3] = hi16(cq[1]);
      qq[4] = lo16(cq[2]); qq[5] = hi16(cq[2]); qq[6] = lo16(cq[3]); qq[7] = hi16(cq[3]);
      const float a = cab.x, beta = cab.y;
      float ov[NV];
#pragma unroll
      for (int i = 0; i < NV; ++i) {
        float ks0 = S[i][0] * kk[0], ks1 = S[i][1] * kk[1];
#pragma unroll
        for (int j = 2; j < 8; j += 2) { ks0 += S[i][j] * kk[j]; ks1 += S[i][j + 1] * kk[j + 1]; }
        const float ks = red16(ks0 + ks1);
        const float u = beta * (vv[i] - a * ks);
#pragma unroll
        for (int j = 0; j < 8; ++j) S[i][j] = a * S[i][j] + kk[j] * u;
        float o0 = S[i][0] * qq[0], o1 = S[i][1] * qq[1];
#pragma unroll
        for (int j = 2; j < 8; j += 2) { o0 += S[i][j] * qq[j]; o1 += S[i][j + 1] * qq[j + 1]; }
        ov[i] = red16(o0 + o1);
      }
      if (kg == 0) {
        bf16_t* op = proj + (size_t)(tok0 + c * 16 + t) * DINS + 768 + h * 128 + vcol;
        if (NV == 8) {
          *(u32x4*)op = (u32x4){pack2(ov[0], ov[1 % NV]), pack2(ov[2 % NV], ov[3 % NV]), pack2(ov[4 % NV], ov[5 % NV]), pack2(ov[6 % NV], ov[7 % NV])};
        } else {
#pragma unroll
          for (int i = 0; i < NV; ++i) op[i] = (bf16_t)f2bf(ov[i]);
        }
      }
    }
    if (c + 1 < nch) lstore((c + 1) & 1);
    __syncthreads();
  }
  float* so = p.out + (smp ? O_SGDN : O_PGDN) + ((size_t)(l * NB + seq) * 4 + h) * 16384 + (size_t)(kg * 8) * 128 + vcol;
#pragma unroll
  for (int j = 0; j < 8; ++j) {
    if (NV == 8) {
      stnt4(so + j * 128, make_float4(S[0][j], S[1 % NV][j], S[2 % NV][j], S[3 % NV][j]));
      stnt4(so + j * 128 + 4, make_float4(S[4 % NV][j], S[5 % NV][j], S[6 % NV][j], S[7 % NV][j]));
    } else {
#pragma unroll
      for (int i = 0; i < NV; ++i) so[j * 128 + i] = S[i][j];
    }
  }
}

template <int NE>
__device__ void ml_block(const Params& p, int l, int smp, int id, char* smem) {
  constexpr int NEH = 2 / NE;
  constexpr int VB = 64 * NE;
  constexpr int BUF = 4096 + 16 * VB + 128;
  const int tid = otid(), lane = tid & 63, w = tid >> 6;
  const int dg = lane & 7, ei = lane >> 3;
  const int eh = id % NEH, h = (id / NEH) & 3, seq = id / (NEH * 4);
  const int eloc = (w * 8 + ei) * NE;
  const int ecol = eh * 32 * NE + eloc;
  const int T = smp ? 8 : 2048, NB = smp ? 128 : 8;
  const int tok0 = smp ? NPR + seq * 8 : seq * 2048;
  const int tlast = tok0 + T - 1;
  bf16_t* proj = (bf16_t*)(p.ws + WS_PROJ);
  const float* gates = (const float*)(p.ws + WS_GATES);
  float C[NE][8], nv[8], m;
  if (smp) {
    const float* c0 = p.in[5] + ((size_t)(l * 128 + seq) * 4 + h) * 4096 + (size_t)(dg * 8) * 64 + ecol;
    const float* n0 = p.in[6] + ((size_t)(l * 128 + seq) * 4 + h) * 64 + dg * 8;
#pragma unroll
    for (int j = 0; j < 8; ++j) {
#pragma unroll
      for (int i = 0; i < NE; ++i) C[i][j] = __builtin_nontemporal_load(c0 + j * 64 + i);
      nv[j] = n0[j];
    }
    m = p.in[7][(size_t)(l * 128 + seq) * 4 + h];
  } else {
#pragma unroll
    for (int j = 0; j < 8; ++j) {
#pragma unroll
      for (int i = 0; i < NE; ++i) C[i][j] = 0.f;
      nv[j] = 0.f;
    }
    m = 0.f;
  }
  const int ltok = (tid & 127) >> 3, lpart = tid & 7, lk = tid >> 7;
  const int vtok = tid / (4 * NE), vpart = tid % (4 * NE);
  const int gtok = (tid & 31) >> 1, gwhich = tid & 1;
  u32x4 rqk, rv = (u32x4){0u, 0u, 0u, 0u}; float rg = 0.f;
  const int nch = (T + 15) >> 4;
  auto gload = [&](int c) {
    int tk = tok0 + c * 16 + ltok; tk = tk > tlast ? tlast : tk;
    rqk = *(const u32x4*)(proj + (size_t)tk * DINS + 2824 + lk * 256 + h * 64 + lpart * 8);
    if (tid < 64 * NE) {
      int tv = tok0 + c * 16 + vtok; tv = tv > tlast ? tlast : tv;
      rv = *(const u32x4*)(proj + (size_t)tv * DINS + 3336 + h * 64 + eh * 32 * NE + vpart * 8);
    }
    if (tid < 32) {
      int tg = tok0 + c * 16 + gtok; tg = tg > tlast ? tlast : tg;
      rg = gates[(size_t)tg * 16 + 8 + gwhich * 4 + h];
    }
  };
  auto lstore = [&](int b) {
    char* B = smem + b * BUF;
    *(u32x4*)(B + lk * 2048 + ltok * 128 + lpart * 16) = rqk;
    if (tid < 64 * NE) *(u32x4*)(B + 4096 + vtok * VB + vpart * 16) = rv;
    if (tid < 32) *(float*)(B + 4096 + 16 * VB + gtok * 8 + gwhich * 4) = rg;
  };
  __syncthreads();
  gload(0);
  lstore(0);
  __syncthreads();
  for (int c = 0; c < nch; ++c) {
    if (c + 1 < nch) gload(c + 1);
    const char* B = smem + (c & 1) * BUF;
    const int nt = (T - c * 16) < 16 ? (T - c * 16) : 16;
#pragma unroll 4
    for (int t = 0; t < nt; ++t) {
      const u32x4 cq = *(const u32x4*)(B + t * 128 + dg * 16), ck = *(const u32x4*)(B + 2048 + t * 128 + dg * 16);
      const float2 cg = *(const float2*)(B + 4096 + 16 * VB + t * 8);
      float vv[NE];
      if (NE == 2) {
        const unsigned cv = *(const unsigned*)(B + 4096 + t * VB + eloc * 2);
        vv[0] = lo16(cv); vv[1 % NE] = hi16(cv);
      } else {
        vv[0] = bf2f(*(const unsigned short*)(B + 4096 + t * VB + eloc * 2));
      }
      float qq[8], kk[8];
      qq[0] = lo16(cq[0]); qq[1] = hi16(cq[0]); qq[2] = lo16(cq[1]); qq[3] = hi16(cq[1]);
      qq[4] = lo16(cq[2]); qq[5] = hi16(cq[2]); qq[6] = lo16(cq[3]); qq[7] = hi16(cq[3]);
      kk[0] = lo16(ck[0]); kk[1] = hi16(ck[0]); kk[2] = lo16(ck[1]); kk[3] = hi16(ck[1]);
      kk[4] = lo16(ck[2]); kk[5] = hi16(ck[2]); kk[6] = lo16(ck[3]); kk[7] = hi16(ck[3]);
      const float ig = cg.x, lf = cg.y;
      const float mn = fmaxf(lf + m, ig);
      const float dc = __expf(lf + m - mn);
      const float wk = __expf(ig - mn) * 0.125f;
      float qn0 = 0.f, qn1 = 0.f;
#pragma unroll
      for (int j = 0; j < 8; j += 2) {
        nv[j] = dc * nv[j] + kk[j] * wk; nv[j + 1] = dc * nv[j + 1] + kk[j + 1] * wk;
        qn0 += qq[j] * nv[j]; qn1 += qq[j + 1] * nv[j + 1];
      }
      const float qn = red8(qn0 + qn1);
      const float rden = __builtin_amdgcn_rcpf(fmaxf(fabsf(qn), __expf(-mn)));
      float hv[NE];
#pragma unroll
      for (int i = 0; i < NE; ++i) {
        const float wkv = wk * vv[i];
        float n0 = 0.f, n1 = 0.f;
#pragma unroll
        for (int j = 0; j < 8; j += 2) {
          C[i][j] = dc * C[i][j] + kk[j] * wkv; C[i][j + 1] = dc * C[i][j + 1] + kk[j + 1] * wkv;
          n0 += qq[j] * C[i][j]; n1 += qq[j + 1] * C[i][j + 1];
        }
        hv[i] = red8(n0 + n1) * rden;
      }
      if (dg == 0) {
        bf16_t* op = proj + (size_t)(tok0 + c * 16 + t) * DINS + 1280 + h * 64 + ecol;
        if (NE == 2) *(unsigned*)op = pack2(hv[0], hv[1 % NE]);
        else op[0] = (bf16_t)f2bf(hv[0]);
      }
      m = mn;
    }
    if (c + 1 < nch) lstore((c + 1) & 1);
    __syncthreads();
  }
  float* co = p.out + (smp ? O_SC : O_PC) + ((size_t)(l * NB + seq) * 4 + h) * 4096 + (size_t)(dg * 8) * 64 + ecol;
#pragma unroll
  for (int j = 0; j < 8; ++j)
#pragma unroll
    for (int i = 0; i < NE; ++i) __builtin_nontemporal_store(C[i][j], co + j * 64 + i);
  if (eh == 0 && w == 0 && ei == 0) {
    float* no = p.out + (smp ? O_SN : O_PN) + ((size_t)(l * NB + seq) * 4 + h) * 64 + dg * 8;
#pragma unroll
    for (int j = 0; j < 8; ++j) no[j] = nv[j];
    if (dg == 0) p.out[(smp ? O_SM : O_PM) + (size_t)(l * NB + seq) * 4 + h] = m;
  }
}

#define YREC_ELEMS 12288
template <int MF, int NF, int KS>
__device__ __forceinline__ void mm_lds(f32x4 (&acc)[MF][NF], const bf16_t* A, int lda, const bf16_t* Bt, int ldb, int l15, int l4) {
#pragma unroll
  for (int ks = 0; ks < KS; ++ks) {
    bf16x8 a[MF], b[NF];
#pragma unroll
    for (int i = 0; i < MF; ++i) a[i] = *(const bf16x8*)(A + (i * 16 + l15) * lda + ks * 32 + l4 * 8);
#pragma unroll
    for (int j = 0; j < NF; ++j) b[j] = *(const bf16x8*)(Bt + (j * 16 + l15) * ldb + ks * 32 + l4 * 8);
#pragma unroll
    for (int i = 0; i < MF; ++i)
#pragma unroll
      for (int j = 0; j < NF; ++j) acc[i][j] = __builtin_amdgcn_mfma_f32_16x16x32_bf16(b[j], a[i], acc[i][j], 0, 0, 0);
  }
}

template <int II>
__device__ __forceinline__ void solve_rows(float (&wv)[64], const float* sM, const float* sF, const bf16_t* src) {
  if constexpr (II < 64) {
    float s0 = sF[II] * bf2f(src[II * 136]), s1 = 0.f, s2 = 0.f, s3 = 0.f;
#pragma unroll
    for (int j4 = 0; j4 < (II + 3) / 4; ++j4) {
      const float4 m = *(const float4*)(sM + II * 68 + j4 * 4);
      if (j4 * 4 + 0 < II) s0 -= m.x * wv[j4 * 4 + 0];
      if (j4 * 4 + 1 < II) s1 -= m.y * wv[j4 * 4 + 1];
      if (j4 * 4 + 2 < II) s2 -= m.z * wv[j4 * 4 + 2];
      if (j4 * 4 + 3 < II) s3 -= m.w * wv[j4 * 4 + 3];
    }
    wv[II] = (s0 + s1) + (s2 + s3);
    __builtin_amdgcn_sched_barrier(0);
    solve_rows<II + 1>(wv, sM, sF, src);
  }
}
template <int II>
__device__ __forceinline__ void store_rows(const float (&wv)[64], bf16_t* dst, float sgn) {
  if constexpr (II < 64) {
    dst[(size_t)II * 512] = (bf16_t)f2bf(sgn * wv[II]);
    store_rows<II + 1>(wv, dst, sgn);
  }
}

__device__ void gdn_k1(const Params& p, int l, int unit, char* smem) {
  const int tid = otid(), lane = tid & 63, w = tid >> 6, l15 = lane & 15, l4 = lane >> 4;
  const int c = unit & 31, h = (unit >> 5) & 3, b = unit >> 7;
  const int tok0 = b * 2048 + c * 64;
  bf16_t* qkvp = (bf16_t*)(p.ws + WS_QKV);
  const float* gates = (const float*)(p.ws + WS_GATES);
  bf16_t* yrec = (bf16_t*)(p.out + O_Y) + (size_t)unit * YREC_ELEMS;
  bf16_t* sQ = (bf16_t*)smem;
  bf16_t* sK = (bf16_t*)(smem + 17408);
  bf16_t* sV = (bf16_t*)(smem + 34816);
  float* sG = (float*)(smem + 52224);
  float* sBe = (float*)(smem + 52480);
  float* sg = (float*)(smem + 52736);
  float* sF = (float*)(smem + 52992);
  float* sM = (float*)smem;
  __syncthreads();
#pragma unroll
  for (int x = 0; x < 4; ++x) {
    const int ch = tid + 256 * x, r = ch >> 4, cc = (ch & 15) * 8;
    const bf16_t* g = qkvp + (size_t)(tok0 + r) * 512 + h * 128 + cc;
    *(u32x4*)(sQ + r * 136 + cc) = *(const u32x4*)g;
    *(u32x4*)(sK + r * 136 + cc) = *(const u32x4*)(g + QPART);
    *(u32x4*)(sV + r * 136 + cc) = *(const u32x4*)(g + 2 * QPART);
  }
  if (tid < 64) {
    sg[tid] = __logf(gates[(size_t)(tok0 + tid) * 16 + h]);
    sBe[tid] = gates[(size_t)(tok0 + tid) * 16 + 4 + h];
  }
  __syncthreads();
  if (tid < 64) { float s = 0.f; for (int j = 0; j <= tid; ++j) s += sg[j]; sG[tid] = s; sF[tid] = sBe[tid]; sF[64 + tid] = sBe[tid] * __expf(s); }
  __syncthreads();
  f32x4 kk[1][4], qk[1][4];
#pragma unroll
  for (int j = 0; j < 4; ++j) { kk[0][j] = (f32x4){0.f, 0.f, 0.f, 0.f}; qk[0][j] = (f32x4){0.f, 0.f, 0.f, 0.f}; }
  mm_lds<1, 4, 4>(kk, sK + 16 * w * 136, 136, sK, 136, l15, l4);
  mm_lds<1, 4, 4>(qk, sQ + 16 * w * 136, 136, sK, 136, l15, l4);
  const int i = 16 * w + l15;
  const float Gi = sG[i], bi = sBe[i], G63 = sG[63];
#pragma unroll
  for (int nf = 0; nf < 4; ++nf) {
    float qv[4];
#pragma unroll
    for (int r = 0; r < 4; ++r) {
      const int j = 16 * nf + 4 * l4 + r;
      const float dec = (j <= i) ? __expf(Gi - sG[j]) : 0.f;
      kk[0][nf][r] = (j < i) ? bi * kk[0][nf][r] * dec : 0.f;
      qv[r] = qk[0][nf][r] * dec;
    }
    *(uint2*)(yrec + i * 64 + 16 * nf + 4 * l4) = make_uint2(pack2(qv[0], qv[1]), pack2(qv[2], qv[3]));
  }
  {
    const int r = tid >> 2, c0 = (tid & 3) * 32;
    const float e = __expf(sG[r]);
    bf16_t* dst = qkvp + (size_t)(tok0 + r) * 512 + h * 128 + c0;
#pragma unroll
    for (int x = 0; x < 4; ++x) {
      u32x4 u = *(const u32x4*)(sQ + r * 136 + c0 + x * 8);
      u32x4 o;
#pragma unroll
      for (int y = 0; y < 4; ++y) o[y] = pack2(lo16(u[y]) * e, hi16(u[y]) * e);
      *(u32x4*)(dst + x * 8) = o;
    }
    const int kc = tid & 127, ih = tid >> 7;
#pragma unroll
    for (int x = 0; x < 4; ++x) {
      const int i0 = ih * 32 + x * 8;
      float v[8];
#pragma unroll
      for (int y = 0; y < 8; ++y) v[y] = bf2f(sK[(i0 + y) * 136 + kc]) * __expf(G63 - sG[i0 + y]);
      *(u32x4*)(yrec + 4096 + kc * 64 + i0) = (u32x4){pack2(v[0], v[1]), pack2(v[2], v[3]), pack2(v[4], v[5]), pack2(v[6], v[7])};
    }
  }
  __syncthreads();
#pragma unroll
  for (int nf = 0; nf < 4; ++nf)
    *(float4*)(sM + i * 68 + 16 * nf + 4 * l4) = make_float4(kk[0][nf][0], kk[0][nf][1], kk[0][nf][2], kk[0][nf][3]);
  __syncthreads();
  {
    float wv[64];
    const int col = tid & 127;
    const bool isv = tid < 128;
    solve_rows<0>(wv, sM, sF + (isv ? 0 : 64), (isv ? sV : sK) + col);
    bf16_t* dst = qkvp + (isv ? 2 : 1) * QPART + (size_t)tok0 * 512 + h * 128 + col;
    const float sgn = isv ? 1.f : -1.f;
    store_rows<0>(wv, dst, sgn);
  }
  if (tid == 0) ((float*)(p.ws + WS_EL))[unit] = __expf(G63);
}

__device__ void gdn_k2(const Params& p, int l, int task, char* smem) {
  const int tid = otid(), lane = tid & 63, w = tid >> 6, l15 = lane & 15, l4 = lane >> 4;
  const int vh = task & 1, sh = task >> 1, h = sh & 3, b = sh >> 2;
  const int vcol = vh * 64 + 16 * w + l15;
  const bf16_t* qkvp = (const bf16_t*)(p.ws + WS_QKV);
  bf16_t* proj = (bf16_t*)(p.ws + WS_PROJ);
  const float* EL = (const float*)(p.ws + WS_EL);
  bf16_t* sWk = (bf16_t*)smem;
  bf16_t* sQg = (bf16_t*)(smem + 17408);
  bf16_t* sQK = (bf16_t*)(smem + 34816);
  bf16_t* sKd = (bf16_t*)(smem + 44032);
  f32x4 S[8];
#pragma unroll
  for (int nf = 0; nf < 8; ++nf) S[nf] = (f32x4){0.f, 0.f, 0.f, 0.f};
  u32x4 st[14];
  unsigned wvp[16];
  auto gload = [&](int c) {
    const int tok0 = b * 2048 + c * 64;
    const bf16_t* yrec = (const bf16_t*)(p.out + O_Y) + (size_t)((b * 4 + h) * 32 + c) * YREC_ELEMS;
#pragma unroll
    for (int x = 0; x < 4; ++x) {
      const int ch = tid + 256 * x, r = ch >> 4, cc = (ch & 15) * 8;
      const bf16_t* g = qkvp + (size_t)(tok0 + r) * 512 + h * 128 + cc;
      st[x] = *(const u32x4*)(g + QPART);
      st[4 + x] = *(const u32x4*)g;
      st[10 + x] = *(const u32x4*)(yrec + 4096 + ch * 8);
    }
#pragma unroll
    for (int x = 0; x < 2; ++x) st[8 + x] = *(const u32x4*)(yrec + (tid + 256 * x) * 8);
#pragma unroll
    for (int nf = 0; nf < 4; ++nf) {
      const bf16_t* g = qkvp + 2 * QPART + (size_t)(tok0 + 16 * nf + 4 * l4) * 512 + h * 128 + vcol;
#pragma unroll
      for (int r = 0; r < 4; ++r) wvp[nf * 4 + r] = g[(size_t)r * 512];
    }
  };
  auto lstore = [&]() {
#pragma unroll
    for (int x = 0; x < 4; ++x) {
      const int ch = tid + 256 * x, r = ch >> 4, cc = (ch & 15) * 8;
      *(u32x4*)(sWk + r * 136 + cc) = st[x];
      *(u32x4*)(sQg + r * 136 + cc) = st[4 + x];
      *(u32x4*)(sKd + (ch >> 3) * 72 + (ch & 7) * 8) = st[10 + x];
    }
#pragma unroll
    for (int x = 0; x < 2; ++x) { const int ch = tid + 256 * x; *(u32x4*)(sQK + (ch >> 3) * 72 + (ch & 7) * 8) = st[8 + x]; }
  };
  auto bperm = [&](const bf16_t* Bt, int ld, int row, int s) -> bf16x8 {
    const uint2 lo = *(const uint2*)(Bt + row * ld + 32 * s + 4 * l4);
    const uint2 hi = *(const uint2*)(Bt + row * ld + 32 * s + 16 + 4 * l4);
    u32x4 u = (u32x4){lo.x, lo.y, hi.x, hi.y};
    return __builtin_bit_cast(bf16x8, u);
  };
  auto afrag = [&](const f32x4& x0, const f32x4& x1) -> bf16x8 {
    u32x4 u = (u32x4){pack2(x0[0], x0[1]), pack2(x0[2], x0[3]), pack2(x1[0], x1[1]), pack2(x1[2], x1[3])};
    return __builtin_bit_cast(bf16x8, u);
  };
  __syncthreads();
  gload(0);
  for (int c = 0; c < 32; ++c) {
    const int tok0 = b * 2048 + c * 64;
    lstore();
    f32x4 uT[4], oT[4];
#pragma unroll
    for (int nf = 0; nf < 4; ++nf) {
#pragma unroll
      for (int r = 0; r < 4; ++r) uT[nf][r] = bf2f(wvp[nf * 4 + r]);
      oT[nf] = (f32x4){0.f, 0.f, 0.f, 0.f};
    }
    __syncthreads();
    if (c + 1 < 32) gload(c + 1);
    const float eL = EL[(b * 4 + h) * 32 + c];
#pragma unroll
    for (int s = 0; s < 4; ++s) {
      const bf16x8 aS = afrag(S[2 * s], S[2 * s + 1]);
#pragma unroll
      for (int nf = 0; nf < 4; ++nf) {
        const bf16x8 bw = bperm(sWk, 136, 16 * nf + l15, s), bq = bperm(sQg, 136, 16 * nf + l15, s);
        uT[nf] = __builtin_amdgcn_mfma_f32_16x16x32_bf16(bw, aS, uT[nf], 0, 0, 0);
        oT[nf] = __builtin_amdgcn_mfma_f32_16x16x32_bf16(bq, aS, oT[nf], 0, 0, 0);
      }
    }
#pragma unroll
    for (int nf = 0; nf < 8; ++nf) S[nf] *= eL;
#pragma unroll
    for (int s = 0; s < 2; ++s) {
      const bf16x8 aU = afrag(uT[2 * s], uT[2 * s + 1]);
#pragma unroll
      for (int nf = 0; nf < 4; ++nf) {
        const bf16x8 bq = bperm(sQK, 72, 16 * nf + l15, s);
        oT[nf] = __builtin_amdgcn_mfma_f32_16x16x32_bf16(bq, aU, oT[nf], 0, 0, 0);
      }
#pragma unroll
      for (int nf = 0; nf < 8; ++nf) {
        const bf16x8 bk = bperm(sKd, 72, 16 * nf + l15, s);
        S[nf] = __builtin_amdgcn_mfma_f32_16x16x32_bf16(bk, aU, S[nf], 0, 0, 0);
      }
    }
#pragma unroll
    for (int nf = 0; nf < 4; ++nf) {
      bf16_t* g = proj + (size_t)(tok0 + 16 * nf + 4 * l4) * DINS + 768 + h * 128 + vcol;
#pragma unroll
      for (int r = 0; r < 4; ++r) g[(size_t)r * DINS] = (bf16_t)f2bf(oT[nf][r]);
    }
    __syncthreads();
  }
  float* so = p.out + O_PGDN + ((size_t)(l * 8 + b) * 4 + h) * 16384;
#pragma unroll
  for (int nf = 0; nf < 8; ++nf)
#pragma unroll
    for (int r = 0; r < 4; ++r) so[(size_t)(16 * nf + 4 * l4 + r) * 128 + vcol] = S[nf][r];
}

#define MLREC_BF (1024ull * YREC_ELEMS)
#define MLREC_F  12582912ull
__device__ void ml_k1(const Params& p, int l, int unit, char* smem) {
  const int tid = otid(), lane = tid & 63, w = tid >> 6, l15 = lane & 15, l4 = lane >> 4;
  const int c = unit & 31, h = (unit >> 5) & 3, b = unit >> 7;
  const int tok0 = b * 2048 + c * 64;
  const bf16_t* proj = (const bf16_t*)(p.ws + WS_PROJ);
  const float* gates = (const float*)(p.ws + WS_GATES);
  bf16_t* rec = (bf16_t*)(p.out + O_Y) + MLREC_BF + (size_t)unit * YREC_ELEMS;
  float* recf = p.out + O_Y + MLREC_F + (size_t)unit * 320;
  bf16_t* sQ = (bf16_t*)smem;
  bf16_t* sK = (bf16_t*)(smem + 9216);
  bf16_t* sV = (bf16_t*)(smem + 18432);
  float* sA = (float*)(smem + 27648);
  float* slf = (float*)(smem + 27904);
  float* sig = (float*)(smem + 28160);
  float* sCF = (float*)(smem + 28416);
  float* sKS = (float*)(smem + 28672);
  __syncthreads();
#pragma unroll
  for (int x = 0; x < 2; ++x) {
    const int ch = tid + 256 * x, r = ch >> 3, cc = (ch & 7) * 8;
    const bf16_t* g = proj + (size_t)(tok0 + r) * DINS + h * 64 + cc;
    *(u32x4*)(sQ + r * 72 + cc) = *(const u32x4*)(g + 2824);
    *(u32x4*)(sK + r * 72 + cc) = *(const u32x4*)(g + 3080);
    *(u32x4*)(sV + r * 72 + cc) = *(const u32x4*)(g + 3336);
  }
  if (tid < 64) {
    sig[tid] = gates[(size_t)(tok0 + tid) * 16 + 8 + h];
    slf[tid] = gates[(size_t)(tok0 + tid) * 16 + 12 + h];
  }
  __syncthreads();
  if (tid < 64) {
    float F = 0.f;
    for (int j = 0; j <= tid; ++j) F += slf[j];
    sA[tid] = sig[tid] - F;
    recf[tid] = F;
  }
  __syncthreads();
  if (tid < 64) {
    float bm = -3.0e38f, B = -3.0e38f;
    for (int j = 0; j < 64; ++j) { const float a = sA[j]; B = fmaxf(B, a); if (j <= tid) bm = fmaxf(bm, a); }
    recf[64 + tid] = bm;
    sCF[tid] = 0.125f * __expf(sA[tid] - B);
    if (tid == 0) recf[256] = B;
  }
  __syncthreads();
  f32x4 qk[1][4];
#pragma unroll
  for (int j = 0; j < 4; ++j) qk[0][j] = (f32x4){0.f, 0.f, 0.f, 0.f};
  mm_lds<1, 4, 2>(qk, sQ + 16 * w * 72, 72, sK, 72, l15, l4);
  {
    const int i = 16 * w + l15;
    float rsum = 0.f;
#pragma unroll
    for (int nf = 0; nf < 4; ++nf) {
      float pv[4];
#pragma unroll
      for (int r = 0; r < 4; ++r) {
        const int j = 16 * nf + 4 * l4 + r;
        pv[r] = (j <= i) ? qk[0][nf][r] * sCF[j] : 0.f;
        rsum += pv[r];
      }
      *(uint2*)(rec + i * 64 + 16 * nf + 4 * l4) = make_uint2(pack2(pv[0], pv[1]), pack2(pv[2], pv[3]));
    }
    rsum += __shfl_xor(rsum, 16); rsum += __shfl_xor(rsum, 32);
    if (l4 == 0) recf[128 + i] = rsum;
  }
  {
    const int d = tid & 63, jq = tid >> 6;
    float ks = 0.f;
#pragma unroll
    for (int x = 0; x < 2; ++x) {
      const int j0 = jq * 16 + x * 8;
      float kv[8]; unsigned vv[8];
#pragma unroll
      for (int y = 0; y < 8; ++y) { kv[y] = bf2f(sK[(j0 + y) * 72 + d]) * sCF[j0 + y]; ks += kv[y]; vv[y] = sV[(j0 + y) * 72 + d]; }
      *(u32x4*)(rec + 4096 + d * 64 + j0) = (u32x4){pack2(kv[0], kv[1]), pack2(kv[2], kv[3]), pack2(kv[4], kv[5]), pack2(kv[6], kv[7])};
      *(u32x4*)(rec + 8192 + d * 64 + j0) = (u32x4){vv[0] | (vv[1] << 16), vv[2] | (vv[3] << 16), vv[4] | (vv[5] << 16), vv[6] | (vv[7] << 16)};
    }
    sKS[jq * 64 + d] = ks;
  }
  __syncthreads();
  if (tid < 64) recf[192 + tid] = sKS[tid] + sKS[64 + tid] + sKS[128 + tid] + sKS[192 + tid];
}

__device__ void ml_k2(const Params& p, int l, int sh, char* smem) {
  const int tid = otid(), lane = tid & 63, w = tid >> 6, l15 = lane & 15, l4 = lane >> 4;
  const int h = sh & 3, b = sh >> 2;
  const int ecol = 16 * w + l15;
  bf16_t* proj = (bf16_t*)(p.ws + WS_PROJ);
  bf16_t* sQ = (bf16_t*)smem;
  bf16_t* sP = (bf16_t*)(smem + 9216);
  bf16_t* sKc = (bf16_t*)(smem + 18432);
  bf16_t* sVt = (bf16_t*)(smem + 27648);
  float* wn = (float*)(smem + 36864 + w * 1024);
  float* cw1 = wn + 64;
  float* cw2 = wn + 128;
  f32x4 S[4];
#pragma unroll
  for (int nf = 0; nf < 4; ++nf) S[nf] = (f32x4){0.f, 0.f, 0.f, 0.f};
  float nd = 0.f, m = 0.f;
  u32x4 st[8];
  float rF, rb, rrs, rks, rB, rF63;
  auto gload = [&](int c) {
    const int tok0 = b * 2048 + c * 64;
    const int unit = (b * 4 + h) * 32 + c;
    const bf16_t* rec = (const bf16_t*)(p.out + O_Y) + MLREC_BF + (size_t)unit * YREC_ELEMS;
    const float* recf = p.out + O_Y + MLREC_F + (size_t)unit * 320;
#pragma unroll
    for (int x = 0; x < 2; ++x) {
      const int ch = tid + 256 * x, r = ch >> 3, cc = (ch & 7) * 8;
      st[x] = *(const u32x4*)(proj + (size_t)(tok0 + r) * DINS + 2824 + h * 64 + cc);
      st[2 + x] = *(const u32x4*)(rec + ch * 8);
      st[4 + x] = *(const u32x4*)(rec + 4096 + ch * 8);
      st[6 + x] = *(const u32x4*)(rec + 8192 + ch * 8);
    }
    rF = recf[lane]; rb = recf[64 + lane]; rrs = recf[128 + lane]; rks = recf[192 + lane]; rB = recf[256]; rF63 = recf[63];
  };
  auto lstore = [&]() {
#pragma unroll
    for (int x = 0; x < 2; ++x) {
      const int ch = tid + 256 * x, o = (ch >> 3) * 72 + (ch & 7) * 8;
      *(u32x4*)(sQ + o) = st[x];
      *(u32x4*)(sP + o) = st[2 + x];
      *(u32x4*)(sKc + o) = st[4 + x];
      *(u32x4*)(sVt + o) = st[6 + x];
    }
  };
  auto bperm = [&](const bf16_t* Bt, int ld, int row, int s) -> bf16x8 {
    const uint2 lo = *(const uint2*)(Bt + row * ld + 32 * s + 4 * l4);
    const uint2 hi = *(const uint2*)(Bt + row * ld + 32 * s + 16 + 4 * l4);
    u32x4 u = (u32x4){lo.x, lo.y, hi.x, hi.y};
    return __builtin_bit_cast(bf16x8, u);
  };
  auto afrag = [&](const f32x4& x0, const f32x4& x1) -> bf16x8 {
    u32x4 u = (u32x4){pack2(x0[0], x0[1]), pack2(x0[2], x0[3]), pack2(x1[0], x1[1]), pack2(x1[2], x1[3])};
    return __builtin_bit_cast(bf16x8, u);
  };
  __syncthreads();
  gload(0);
  for (int c = 0; c < 32; ++c) {
    const int tok0 = b * 2048 + c * 64;
    lstore();
    const float Fi = rF, bi = rb, rsi = rrs, ksd = rks, B = rB, F63 = rF63;
    __syncthreads();
    if (c + 1 < 32) gload(c + 1);
    wn[lane] = nd;
    const float mv = fmaxf(m, bi);
    const float wI = __expf(m - mv), rf = __expf(B - mv);
    float qdn = 0.f;
#pragma unroll
    for (int x = 0; x < 8; ++x) {
      const u32x4 qv = *(const u32x4*)(sQ + lane * 72 + x * 8);
      const float4 n0 = *(const float4*)(wn + x * 8), n1 = *(const float4*)(wn + x * 8 + 4);
      qdn += lo16(qv[0]) * n0.x + hi16(qv[0]) * n0.y + lo16(qv[1]) * n0.z + hi16(qv[1]) * n0.w
           + lo16(qv[2]) * n1.x + hi16(qv[2]) * n1.y + lo16(qv[3]) * n1.z + hi16(qv[3]) * n1.w;
    }
    const float qn = wI * qdn + rf * rsi;
    const float rden = __builtin_amdgcn_rcpf(fmaxf(fabsf(qn), __expf(-(Fi + mv))));
    cw1[lane] = wI * rden;
    cw2[lane] = rf * rden;
    f32x4 X1[4], X2[1][4], T[1][4];
#pragma unroll
    for (int nf = 0; nf < 4; ++nf) { X1[nf] = (f32x4){0.f, 0.f, 0.f, 0.f}; X2[0][nf] = (f32x4){0.f, 0.f, 0.f, 0.f}; T[0][nf] = (f32x4){0.f, 0.f, 0.f, 0.f}; }
#pragma unroll
    for (int s = 0; s < 2; ++s) {
      const bf16x8 aS = afrag(S[2 * s], S[2 * s + 1]);
#pragma unroll
      for (int nf = 0; nf < 4; ++nf) X1[nf] = __builtin_amdgcn_mfma_f32_16x16x32_bf16(bperm(sQ, 72, 16 * nf + l15, s), aS, X1[nf], 0, 0, 0);
    }
    mm_lds<1, 4, 2>(X2, sVt + 16 * w * 72, 72, sP, 72, l15, l4);
    mm_lds<1, 4, 2>(T, sVt + 16 * w * 72, 72, sKc, 72, l15, l4);
#pragma unroll
    for (int nf = 0; nf < 4; ++nf) {
      const float4 c1 = *(const float4*)(cw1 + 16 * nf + 4 * l4), c2 = *(const float4*)(cw2 + 16 * nf + 4 * l4);
      bf16_t* g = proj + (size_t)(tok0 + 16 * nf + 4 * l4) * DINS + 1280 + h * 64 + ecol;
      g[0] = (bf16_t)f2bf(c1.x * X1[nf][0] + c2.x * X2[0][nf][0]);
      g[(size_t)DINS] = (bf16_t)f2bf(c1.y * X1[nf][1] + c2.y * X2[0][nf][1]);
      g[(size_t)2 * DINS] = (bf16_t)f2bf(c1.z * X1[nf][2] + c2.z * X2[0][nf][2]);
      g[(size_t)3 * DINS] = (bf16_t)f2bf(c1.w * X1[nf][3] + c2.w * X2[0][nf][3]);
    }
    const float mB = fmaxf(m, B);
    const float dc = __expf(m - mB), fac = __expf(B - mB);
#pragma unroll
    for (int nf = 0; nf < 4; ++nf) S[nf] = dc * S[nf] + fac * T[0][nf];
    nd = dc * nd + fac * ksd;
    m = F63 + mB;
    __syncthreads();
  }
  float* co = p.out + O_PC + ((size_t)(l * 8 + b) * 4 + h) * 4096;
#pragma unroll
  for (int nf = 0; nf < 4; ++nf)
#pragma unroll
    for (int r = 0; r < 4; ++r) co[(size_t)(16 * nf + 4 * l4 + r) * 64 + ecol] = S[nf][r];
  if (w == 0) {
    p.out[O_PN + ((size_t)(l * 8 + b) * 4 + h) * 64 + lane] = nd;
    if (lane == 0) p.out[O_PM + (size_t)(l * 8 + b) * 4 + h] = m;
  }
}

__device__ void k1_phase(const Params& p, int l, char* smem) {
  for (int u = obid(); u < 2048; u += ogdim()) { if (u < 1024) gdn_k1(p, l, u, smem); else ml_k1(p, l, u - 1024, smem); }
}

__device__ void scan_task(const Params& p, int l, int task, char* smem) {
  if (task < 64) gdn_k2(p, l, task, smem);
  else if (task < 96) ml_k2(p, l, task - 64, smem);
  else if (task < 608) gdn_block<8>(p, l, 1, task - 96, smem);
  else ml_block<2>(p, l, 1, task - 608, smem);
}
__device__ void scan_phase(const Params& p, int l, char* smem) {
  const int bid = obid(), nb = ogdim();
  if (nb >= 256) {
    if (bid < 96) scan_task(p, l, bid, smem);
    else for (int task = 96 + (bid - 96); task < 1120; task += nb - 96) scan_task(p, l, task, smem);
  } else {
    for (int task = bid; task < 1120; task += nb) scan_task(p, l, task, smem);
  }
}

__device__ void e2_phase(const Params& p, int l) {
  bf16_t* proj = (bf16_t*)(p.ws + WS_PROJ);
  const float* gnw = p.in[14] + l * 128;
  const float* mnw = p.in[17] + l * 256;
  const int lane = otid() & 63;
  const int gw = obid() * 4 + (otid() >> 6), nw = ogdim() * 4;
  const float2 gw2 = *(const float2*)(gnw + lane * 2);
  const float4 mw4 = *(const float4*)(mnw + lane * 4);
  for (int tok = gw; tok < NTOK; tok += 2 * nw) {
    const int tok2 = (tok + nw < NTOK) ? tok + nw : tok;
    bf16_t* rows[2] = {proj + (size_t)tok * DINS, proj + (size_t)tok2 * DINS};
    unsigned uo[2][4], uz[2][4]; uint2 uh[2], ug[2];
#pragma unroll
    for (int rr = 0; rr < 2; ++rr) {
#pragma unroll
      for (int h = 0; h < 4; ++h) {
        uo[rr][h] = *(const unsigned*)(rows[rr] + 768 + h * 128 + lane * 2);
        uz[rr][h] = *(const unsigned*)(rows[rr] + 2304 + h * 128 + lane * 2);
      }
      uh[rr] = *(const uint2*)(rows[rr] + 1280 + lane * 4);
      ug[rr] = *(const uint2*)(rows[rr] + 3592 + lane * 4);
    }
#pragma unroll
    for (int rr = 0; rr < 2; ++rr) {
      if (rr == 1 && tok2 == tok) continue;
      bf16_t* row = rows[rr];
#pragma unroll
      for (int h = 0; h < 4; ++h) {
        const float o0 = lo16(uo[rr][h]), o1 = hi16(uo[rr][h]);
        const float ss = wsum_dpp(o0 * o0 + o1 * o1);
        const float r = rsqrtf(ss * (1.f / 128.f) + 1e-6f);
        const float y0 = o0 * r * gw2.x * siluf_(lo16(uz[rr][h]));
        const float y1 = o1 * r * gw2.y * siluf_(hi16(uz[rr][h]));
        *(unsigned*)(row + 768 + h * 128 + lane * 2) = pack2(y0, y1);
      }
      {
        float h0 = lo16(uh[rr].x) * sigmoidf_(lo16(ug[rr].x));
        float h1 = hi16(uh[rr].x) * sigmoidf_(hi16(ug[rr].x));
        float h2 = lo16(uh[rr].y) * sigmoidf_(lo16(ug[rr].y));
        float h3 = hi16(uh[rr].y) * sigmoidf_(hi16(ug[rr].y));
        float s = h0 + h1 + h2 + h3;
        s += __int_as_float(__builtin_amdgcn_update_dpp(0, __float_as_int(s), 0xB1, 0xf, 0xf, false));
        s += __int_as_float(__builtin_amdgcn_update_dpp(0, __float_as_int(s), 0x4E, 0xf, 0xf, false));
        s += __int_as_float(__builtin_amdgcn_update_dpp(0, __float_as_int(s), 0x141, 0xf, 0xf, false));
        s += __int_as_float(__builtin_amdgcn_update_dpp(0, __float_as_int(s), 0x140, 0xf, 0xf, false));
        const float mu = s * (1.f / 64.f);
        h0 -= mu; h1 -= mu; h2 -= mu; h3 -= mu;
        float vv = h0 * h0 + h1 * h1 + h2 * h2 + h3 * h3;
        vv += __int_as_float(__builtin_amdgcn_update_dpp(0, __float_as_int(vv), 0xB1, 0xf, 0xf, false));
        vv += __int_as_float(__builtin_amdgcn_update_dpp(0, __float_as_int(vv), 0x4E, 0xf, 0xf, false));
        vv += __int_as_float(__builtin_amdgcn_update_dpp(0, __float_as_int(vv), 0x141, 0xf, 0xf, false));
        vv += __int_as_float(__builtin_amdgcn_update_dpp(0, __float_as_int(vv), 0x140, 0xf, 0xf, false));
        const float r = rsqrtf(vv * (1.f / 64.f) + 1e-5f);
        *(uint2*)(row + 1280 + lane * 4) = make_uint2(pack2(h0 * r * mw4.x, h1 * r * mw4.y), pack2(h2 * r * mw4.z, h3 * r * mw4.w));
      }
    }
  }
}

__device__ void ln_phase(const Params& p, const float* g, const float* b, int final_out) {
  float* pre = p.out + O_Y;
  bf16_t* xb = (bf16_t*)(p.ws + WS_XB);
  const int lane = otid() & 63;
  const int gw = obid() * 4 + (otid() >> 6), nw = ogdim() * 4;
  float4 gg[4], bb[4];
#pragma unroll
  for (int i = 0; i < 4; ++i) { gg[i] = *(const float4*)(g + i * 256 + lane * 4); bb[i] = *(const float4*)(b + i * 256 + lane * 4); }
  for (int tok = gw; tok < NTOK; tok += 2 * nw) {
    const int tok2 = (tok + nw < NTOK) ? tok + nw : tok;
    float* row[2] = {pre + (size_t)tok * 1024, pre + (size_t)tok2 * 1024};
    float4 v[2][4];
#pragma unroll
    for (int rr = 0; rr < 2; ++rr)
#pragma unroll
      for (int i = 0; i < 4; ++i) v[rr][i] = *(const float4*)(row[rr] + i * 256 + lane * 4);
#pragma unroll
    for (int rr = 0; rr < 2; ++rr) {
      float s = 0.f;
#pragma unroll
      for (int i = 0; i < 4; ++i) s += v[rr][i].x + v[rr][i].y + v[rr][i].z + v[rr][i].w;
      const float mu = wsum_dpp(s) * (1.f / 1024.f);
      float q = 0.f;
#pragma unroll
      for (int i = 0; i < 4; ++i) {
        v[rr][i].x -= mu; v[rr][i].y -= mu; v[rr][i].z -= mu; v[rr][i].w -= mu;
        q += v[rr][i].x * v[rr][i].x + v[rr][i].y * v[rr][i].y + v[rr][i].z * v[rr][i].z + v[rr][i].w * v[rr][i].w;
      }
      const float r = rsqrtf(wsum_dpp(q) * (1.f / 1024.f) + 1e-5f);
      const int tk = rr ? tok2 : tok;
      if (rr == 1 && tok2 == tok) continue;
#pragma unroll
      for (int i = 0; i < 4; ++i) {
        const int c = i * 256 + lane * 4;
        float4 y;
        y.x = v[rr][i].x * r * gg[i].x + bb[i].x; y.y = v[rr][i].y * r * gg[i].y + bb[i].y;
        y.z = v[rr][i].z * r * gg[i].z + bb[i].z; y.w = v[rr][i].w * r * gg[i].w + bb[i].w;
        if (final_out) stnt4(row[rr] + c, y);
        else *(uint2*)(xb + (size_t)tk * 1024 + c) = make_uint2(pack2(y.x, y.y), pack2(y.z, y.w));
      }
    }
  }
}

__device__ void e3_phase(const Params& p, int l) {
  bf16_t* hb = (bf16_t*)(p.ws + WS_H);
  const bf16_t* sbb = (const bf16_t*)(p.ws + WS_SB);
  const float* cw = p.in[22] + (size_t)l * 3 * DFF;
  const int total = 120 * 2 * 352;
  for (int idx = obid() * 256 + otid(); idx < total; idx += ogdim() * 256) {
    const int fg = idx % 352, rr = (idx / 352) & 1, ti = idx / 704;
    const int mt = (ti / 15) * 16 + (ti % 15) + 1;
    const int f0 = fg * 8, m = mt * 128 + rr;
    const bf16_t* cur = sbb + (size_t)mt * 8 * DFF;
    const bf16_t* prv = sbb + (size_t)(mt - 1) * 8 * DFF;
    const u32x4 ug0 = *(const u32x4*)(cur + (size_t)(rr * 2) * DFF + f0);
    const u32x4 uv = *(const u32x4*)(cur + (size_t)(rr * 2 + 1) * DFF + f0);
    const u32x4 ug1 = rr ? *(const u32x4*)(cur + f0) : *(const u32x4*)(prv + (size_t)(3 * 2) * DFF + f0);
    const u32x4 ug2 = rr ? *(const u32x4*)(prv + (size_t)(3 * 2) * DFF + f0) : *(const u32x4*)(prv + (size_t)(2 * 2) * DFF + f0);
    float w0[8], w1[8], w2[8];
    *(float4*)w0 = *(const float4*)(cw + f0); *(float4*)(w0 + 4) = *(const float4*)(cw + f0 + 4);
    *(float4*)w1 = *(const float4*)(cw + DFF + f0); *(float4*)(w1 + 4) = *(const float4*)(cw + DFF + f0 + 4);
    *(float4*)w2 = *(const float4*)(cw + 2 * DFF + f0); *(float4*)(w2 + 4) = *(const float4*)(cw + 2 * DFF + f0 + 4);
    u32x4 o;
#pragma unroll
    for (int y = 0; y < 4; ++y) {
      const float ha = siluf_(w0[2 * y] * lo16(ug2[y]) + w1[2 * y] * lo16(ug1[y]) + w2[2 * y] * lo16(ug0[y])) * lo16(uv[y]);
      const float hbv = siluf_(w0[2 * y + 1] * hi16(ug2[y]) + w1[2 * y + 1] * hi16(ug1[y]) + w2[2 * y + 1] * hi16(ug0[y])) * hi16(uv[y]);
      o[y] = pack2(ha, hbv);
    }
    *(u32x4*)(hb + (size_t)m * DFF + f0) = o;
  }
}


#define XB_TMO      128
#define XB_XCNT(j)  (256  + 64 * (j))
#define XB_XSUB(j)  (1280 + 64 * (j))
#define XB_XGEN(j)  (2304 + 64 * (j))
#define XB_TOP      3328
#define XB_TOPGEN   3392
#define XCD_BAR_WORDS 3456
#define XB_SPIN_CAP (1u << 18)
__device__ __forceinline__ unsigned xb_ld(unsigned* p)              { return __hip_atomic_load(p, __ATOMIC_RELAXED, __HIP_MEMORY_SCOPE_AGENT); }
__device__ __forceinline__ unsigned xb_add(unsigned* p, unsigned v) { return __hip_atomic_fetch_add(p, v, __ATOMIC_RELAXED, __HIP_MEMORY_SCOPE_AGENT); }
__device__ __forceinline__ unsigned xb_xcc_id() { return (unsigned)__builtin_amdgcn_s_getreg((3 << 11) | 20) & 0xFu; }
#define XB_SPIN(cond, bar) do { unsigned _sp = 0; while (cond) { __builtin_amdgcn_s_sleep(1); \
    if ((++_sp & 255u) == 0u) { if (xb_ld(&(bar)[XB_TMO])) break; if (_sp > XB_SPIN_CAP) { atomicAdd(&(bar)[XB_TMO], 1u); break; } } } } while (0)
struct XcdBarrier { unsigned* bar; unsigned x; volatile LAS unsigned* st; };
__device__ __forceinline__ XcdBarrier xcd_barrier_post(unsigned* bar, volatile LAS unsigned* st) {
  XcdBarrier b; b.bar = bar; b.x = xb_xcc_id(); b.st = st;
  if (threadIdx.x == 0) (void)xb_add(&bar[XB_XCNT(b.x)], 1u);
  return b;
}
__device__ __forceinline__ void xcd_barrier_complete(unsigned* bar, unsigned x, unsigned& nloc, unsigned& nx) {
  const unsigned G = gridDim.x * gridDim.y * gridDim.z;
  unsigned sum, cnt, mine, sp = 0u;
  for (;;) {
    sum = 0u; cnt = 0u; mine = 0u;
#pragma unroll
    for (unsigned j = 0; j < 16; ++j) { const unsigned c = xb_ld(&bar[XB_XCNT(j)]); sum += c; cnt += (c > 0u) ? 1u : 0u; mine = (j == x) ? c : mine; }
    if (sum == G) break;
    __builtin_amdgcn_s_sleep(1);
    if ((++sp & 255u) == 0u) { if (xb_ld(&bar[XB_TMO])) break; if (sp > XB_SPIN_CAP) { atomicAdd(&bar[XB_TMO], 1u); break; } }
  }
  nloc = mine > 0u ? mine : 1u; nx = cnt > 0u ? cnt : 1u;
}
__device__ __forceinline__ void xcd_barrier(const XcdBarrier& b) {
  asm volatile("s_waitcnt vmcnt(0)" ::: "memory");
  __syncthreads();
  if (threadIdx.x == 0) {
    unsigned* bar = b.bar;
    __builtin_amdgcn_s_waitcnt(0);
    unsigned nloc = b.st[0], nx = b.st[1];
    if (nloc == 0u) { xcd_barrier_complete(bar, b.x, nloc, nx); b.st[0] = nloc; b.st[1] = nx; }
    const unsigned old = xb_add(&bar[XB_XSUB(b.x)], 1u);
    const unsigned gen = old / nloc;
    if (old + 1u == (gen + 1u) * nloc) {
      __builtin_amdgcn_fence(__ATOMIC_RELEASE, "agent");
      asm volatile("s_waitcnt vmcnt(0)" ::: "memory");
      const unsigned og = xb_add(&bar[XB_TOP], 1u);
      const unsigned tg = og / nx;
      if (og + 1u == (tg + 1u) * nx) xb_add(&bar[XB_TOPGEN], 1u);
      else XB_SPIN(xb_ld(&bar[XB_TOPGEN]) == tg, bar);
      __builtin_amdgcn_fence(__ATOMIC_ACQUIRE, "agent");
      xb_add(&bar[XB_XGEN(b.x)], 1u);
      asm volatile("s_waitcnt vmcnt(0)" ::: "memory");
    } else {
      XB_SPIN(xb_ld(&bar[XB_XGEN(b.x)]) == gen, bar);
      __builtin_amdgcn_fence(__ATOMIC_ACQUIRE, "agent");
      asm volatile("s_waitcnt vmcnt(0)" ::: "memory");
    }
  }
  __syncthreads();
}

__global__ void __launch_bounds__(256, 2) fwd_megakernel(Params p, int ph_lo, int ph_hi) {
  extern __shared__ __attribute__((aligned(16))) char smem[];
  cg::grid_group grid = cg::this_grid();
  volatile LAS unsigned* st = (volatile LAS unsigned*)(smem + 69632);
  if (threadIdx.x == 0) { st[0] = 0u; st[1] = 0u; st[2] = 0u; st[3] = 0u; }
  __syncthreads();
  XcdBarrier xb = xcd_barrier_post((unsigned*)(p.ws + WS_BAR), st);
  for (int ph = ph_lo; ph < ph_hi; ++ph) {
    if (ph > ph_lo) {
      if (ph_hi > 1000) grid.sync();
      else xcd_barrier(xb);
    }
    if (ph == 0) { convert_x(p); convert_weights(p, 0, smem); continue; }
    const int l = (ph - 1) / 11, s = (ph - 1) % 11;
    switch (s) {
      case 0: gemm_phase<1>(p, l, smem); break;
      case 1: e1_phase(p, l); break;
      case 2: k1_phase(p, l, smem); break;
      case 3: scan_phase(p, l, smem); break;
      case 4: e2_phase(p, l); break;
      case 5: gemm_phase<2>(p, l, smem); break;
      case 6: ln_phase(p, p.in[19] + l * 1024, p.in[20] + l * 1024, 0); break;
      case 7: gemm_phase<3>(p, l, smem); break;
      case 8: e3_phase(p, l); break;
      case 9: gemm_phase<4>(p, l, smem); break;
      case 10:
        ln_phase(p, p.in[24] + l * 1024, p.in[25] + l * 1024, l == 1);
        if (l == 0) convert_weights(p, 1, smem);
        break;
    }
  }
}

extern "C" void kernel_launch(void* const* d_in, const int* in_sizes, int n_in, void* d_out, int out_size,
                              void* d_ws, size_t ws_size, hipStream_t stream) {
  static int grid_blocks = 0;
  if (!grid_blocks) {
    int dev = 0, cus = 0, per_cu = 0;
    hipGetDevice(&dev);
    hipDeviceGetAttribute(&cus, hipDeviceAttributeMultiprocessorCount, dev);
    hipFuncSetAttribute((const void*)fwd_megakernel, hipFuncAttributeMaxDynamicSharedMemorySize, DYN_LDS);
    hipOccupancyMaxActiveBlocksPerMultiprocessor(&per_cu, fwd_megakernel, 256, DYN_LDS);
    if (per_cu > 2) per_cu = 2;
    if (per_cu < 1) per_cu = 1;
    grid_blocks = cus * per_cu;
  }
  Params p{};
  for (int i = 0; i < 26; ++i) p.in[i] = (const float*)d_in[i];
  p.out = (float*)d_out;
  p.ws = (char*)d_ws;
  int lo = 0, hi = 23;
  hipMemsetAsync((char*)d_ws + WS_BAR, 0, 16384, stream);
  void* args[] = {&p, &lo, &hi};
  hipError_t e = hipLaunchCooperativeKernel((void*)fwd_megakernel, dim3(grid_blocks), dim3(256), args, DYN_LDS, stream);
  if (e != hipSuccess) fprintf(stderr, "cooperative launch failed: %s (grid %d)\n", hipGetErrorString(e), grid_blocks);
}
```

```cpp
#include <hip/hip_runtime.h>
#include <hip/hip_cooperative_groups.h>
#include <cstdio>
#include <cstdint>
namespace cg = cooperative_groups;

typedef unsigned short bf16_t;
using bf16x8 = __attribute__((ext_vector_type(8))) short;
using f32x4  = __attribute__((ext_vector_type(4))) float;
using u32x4  = __attribute__((ext_vector_type(4))) unsigned;

#define NTOK   17408
#define NPR    16384
#define DM     1024
#define DIN    3856
#define DINS   4096
#define DINP   3968
#define DFF    2816
#define DUP    5632
#define ALPHA_F 1.4142135623730951f

#define O_Y      0ull
#define O_PCONV  (O_Y + 17825792ull)
#define O_PGCONV (O_PCONV + 8192ull)
#define O_PGDN   (O_PGCONV + 73728ull)
#define O_PC     (O_PGDN + 1048576ull)
#define O_PN     (O_PC + 262144ull)
#define O_PM     (O_PN + 4096ull)
#define O_PFFN   (O_PM + 64ull)
#define O_SCONV  (O_PFFN + 90112ull)
#define O_SGCONV (O_SCONV + 131072ull)
#define O_SGDN   (O_SGCONV + 1179648ull)
#define O_SC     (O_SGDN + 16777216ull)
#define O_SN     (O_SC + 4194304ull)
#define O_SM     (O_SN + 65536ull)
#define O_SFFN   (O_SM + 1024ull)

#define WS_WIN   0ull
#define WS_WO    (WS_WIN + 3968ull * 1024 * 2)
#define WS_WUP   (WS_WO + 1024ull * 1024 * 2)
#define WS_WDN   (WS_WUP + 5632ull * 1024 * 2)
#define WS_XB    (WS_WDN + 1024ull * 2816 * 2)
#define WS_C     (WS_XB + (unsigned long long)NTOK * 1024 * 2)
#define WS_PROJ  WS_C
#define WS_QKV   (WS_C + (unsigned long long)NTOK * DINS * 2)
#define WS_UP    WS_C
#define WS_H     WS_C
#define WS_SB    (WS_C + (unsigned long long)NTOK * DFF * 2)
#define WS_GATES (WS_C + (unsigned long long)NTOK * DUP * 2)
#define WS_BAR   (WS_GATES + (unsigned long long)NTOK * 16 * 4)
#define WS_EL    (WS_BAR + 16384ull)
#define WS_END   (WS_EL + 4096ull)

#define DYN_LDS (69632 + 16)
#define LAS __attribute__((address_space(3)))

struct Params {
  const float* in[26];
  float* out;
  char* ws;
};

__device__ __forceinline__ float bf2f(unsigned b) { return __uint_as_float(b << 16); }
typedef __bf16 bf16v2 __attribute__((ext_vector_type(2)));
typedef float f32v2 __attribute__((ext_vector_type(2)));
__device__ __forceinline__ unsigned pack2(float a, float b) {
  f32v2 v = {a, b};
  return __builtin_bit_cast(unsigned, __builtin_convertvector(v, bf16v2));
}
__device__ __forceinline__ unsigned f2bf(float f) { return pack2(f, 0.f) & 0xffffu; }
__device__ __forceinline__ float4 ldnt4(const float* p) {
  const f32x4 v = __builtin_nontemporal_load((const f32x4*)p);
  return make_float4(v[0], v[1], v[2], v[3]);
}
__device__ __forceinline__ void stnt4(float* p, float4 v) {
  __builtin_nontemporal_store((f32x4){v.x, v.y, v.z, v.w}, (f32x4*)p);
}
__device__ __forceinline__ float lo16(unsigned u) { return __uint_as_float(u << 16); }
__device__ __forceinline__ float hi16(unsigned u) { return __uint_as_float(u & 0xffff0000u); }
__device__ __forceinline__ float wsum(float v) {
#pragma unroll
  for (int o = 32; o >= 1; o >>= 1) v += __shfl_xor(v, o);
  return v;
}
__device__ __forceinline__ float sigmoidf_(float x) { return 1.f / (1.f + __expf(-x)); }
__device__ __forceinline__ float siluf_(float x) { return x / (1.f + __expf(-x)); }
__device__ __forceinline__ float softplusf_(float x) { return x > 20.f ? x : log1pf(__expf(x)); }

__device__ __forceinline__ int otid() { int t = threadIdx.x; asm volatile("" : "+v"(t)); return t; }
__device__ __forceinline__ int obid() { int b = blockIdx.x; asm volatile("" : "+s"(b)); return b; }
__device__ __forceinline__ int ogdim() { int b = gridDim.x; asm volatile("" : "+s"(b)); return b; }

__device__ __forceinline__ float wsum_dpp(float v) {
  v += __int_as_float(__builtin_amdgcn_update_dpp(0, __float_as_int(v), 0xB1, 0xf, 0xf, false));
  v += __int_as_float(__builtin_amdgcn_update_dpp(0, __float_as_int(v), 0x4E, 0xf, 0xf, false));
  v += __int_as_float(__builtin_amdgcn_update_dpp(0, __float_as_int(v), 0x141, 0xf, 0xf, false));
  v += __int_as_float(__builtin_amdgcn_update_dpp(0, __float_as_int(v), 0x140, 0xf, 0xf, false));
  v += __shfl_xor(v, 16); v += __shfl_xor(v, 32);
  return v;
}

struct TokInfo { int smp, seq, t, T, NB; };
__device__ __forceinline__ TokInfo tokinfo(int tok) {
  TokInfo r;
  if (tok < NPR) { r.smp = 0; r.seq = tok >> 11; r.t = tok & 2047; r.T = 2048; r.NB = 8; }
  else { int u = tok - NPR; r.smp = 1; r.seq = u >> 3; r.t = u & 7; r.T = 8; r.NB = 128; }
  return r;
}

__device__ void convert_weights(const Params& p, int l, char* smem) {
  float (*tile)[65] = (float (*)[65])smem;
  const int tid = otid();
  const int T_IN = 16 * 62, T_O = 16 * 16, T_UP = 16 * 88, T_DN = 44 * 16;
  const int total = T_IN + T_O + T_UP + T_DN;
  for (int ti = obid(); ti < total; ti += ogdim()) {
    const float* src; bf16_t* dst; int K, N, NP, t = ti;
    if (t < T_IN) { src = p.in[9] + (size_t)l * 1024 * DIN; dst = (bf16_t*)(p.ws + WS_WIN); K = 1024; N = DIN; NP = DINP; }
    else if ((t -= T_IN) < T_O) { src = p.in[18] + (size_t)l * 1024 * 1024; dst = (bf16_t*)(p.ws + WS_WO); K = 1024; N = 1024; NP = 1024; }
    else if ((t -= T_O) < T_UP) { src = p.in[21] + (size_t)l * 1024 * DUP; dst = (bf16_t*)(p.ws + WS_WUP); K = 1024; N = DUP; NP = DUP; }
    else { t -= T_UP; src = p.in[23] + (size_t)l * DFF * 1024; dst = (bf16_t*)(p.ws + WS_WDN); K = DFF; N = 1024; NP = 1024; }
    const int tn = NP / 64;
    const int kt = t / tn, nt = t % tn;
#pragma unroll
    for (int ps = 0; ps < 4; ++ps) {
      int r = (tid >> 4) + ps * 16, c = (tid & 15) * 4;
      int n = nt * 64 + c;
      float4 v = make_float4(0.f, 0.f, 0.f, 0.f);
      if (n < N) v = ldnt4(src + (size_t)(kt * 64 + r) * N + n);
      tile[r][c] = v.x; tile[r][c + 1] = v.y; tile[r][c + 2] = v.z; tile[r][c + 3] = v.w;
    }
    __syncthreads();
    {
      int nl = tid >> 2, kq = tid & 3;
      unsigned u[8];
#pragma unroll
      for (int j = 0; j < 8; ++j) u[j] = pack2(tile[kq * 16 + 2 * j][nl], tile[kq * 16 + 2 * j + 1][nl]);
      int nrow = nt * 64 + nl;
      if (N == DUP) {
        const int isv = nrow >= DFF, f = isv ? nrow - DFF : nrow;
        nrow = (f >> 6) * 128 + ((f >> 5) & 1) * 64 + (((f >> 2) & 1) + 2 * isv) * 16 + ((f >> 3) & 3) * 4 + (f & 3);
      }
      uint4* d = (uint4*)(dst + (size_t)nrow * K + kt * 64 + kq * 16);
      d[0] = make_uint4(u[0], u[1], u[2], u[3]);
      d[1] = make_uint4(u[4], u[5], u[6], u[7]);
    }
    __syncthreads();
  }
}

__device__ void convert_x(const Params& p) {
  bf16_t* xb = (bf16_t*)(p.ws + WS_XB);
  const size_t n8 = (size_t)NTOK * 1024 / 8;
  const size_t npr8 = (size_t)NPR * 1024 / 8;
  for (size_t i = (size_t)obid() * 256 + otid(); i < n8; i += (size_t)ogdim() * 256) {
    const float* s = (i < npr8) ? (p.in[0] + i * 8) : (p.in[1] + (i - npr8) * 8);
    float4 a = ldnt4(s), b = ldnt4(s + 4);
    *(uint4*)(xb + i * 8) = make_uint4(pack2(a.x, a.y), pack2(a.z, a.w), pack2(b.x, b.y), pack2(b.z, b.w));
  }
}

#define GBUF 34816
#define LDS_STRIDE 72
template <int MODE>
__device__ void gemm_phase(const Params& p, int l, char* smem) {
  constexpr int K = (MODE == 4) ? DFF : 1024;
  constexpr int NT = (MODE == 1) ? 30 : (MODE == 3) ? 44 : 8;
  constexpr int LDA = (MODE == 1 || MODE == 3) ? 1024 : (MODE == 2) ? DINS : DFF;
  const bf16_t* A = (MODE == 1 || MODE == 3) ? (const bf16_t*)(p.ws + WS_XB)
                  : (MODE == 2) ? (const bf16_t*)(p.ws + WS_PROJ)
                                : (const bf16_t*)(p.ws + WS_H);
  const bf16_t* Bt = (const bf16_t*)(p.ws + ((MODE == 1) ? WS_WIN : (MODE == 2) ? WS_WO : (MODE == 3) ? WS_WUP : WS_WDN));
  bf16_t* sA = (bf16_t*)smem;
  bf16_t* sB = sA + 128 * 64;
  const int tid = otid(), lane = tid & 63, w = tid >> 6, wm = w >> 1, wn = w & 1;
  const int lr = tid >> 3, lc = (tid & 7) * 8;
  const int l15 = lane & 15, l4 = lane >> 4;
  const int wsw = (((tid & 7) ^ ((lr >> 1) & 7)) * 8);
  const int rsw0 = ((l4 ^ ((l15 >> 1) & 7)) * 8), rsw1 = (((l4 + 4) ^ ((l15 >> 1) & 7)) * 8);

  constexpr int PN = (NT + 7) / 8;
  const int bid_ = obid(), gd_ = ogdim();
  const bool swz = (gd_ == 512) && (MODE == 2 || MODE == 4);
  const int nwork = swz ? ((17 * PN + 7) / 8) * 512 : 136 * NT;
  for (int wi = bid_; wi < nwork; wi += gd_) {
    int mt, nt;
    if (swz) {
      const int patch = (wi >> 9) * 8 + (bid_ & 7);
      const int j = bid_ >> 3;
      const int pn = patch / 17, pm = patch % 17;
      mt = pm * 8 + (j >> 3); nt = pn * 8 + (j & 7);
      if (pn >= PN || nt >= NT) continue;
    } else { mt = wi / NT; nt = wi % NT; }
    const int m0 = mt * 128, n0 = nt * 128;
    f32x4 acc[4][4];
#pragma unroll
    for (int i = 0; i < 4; ++i)
#pragma unroll
      for (int j = 0; j < 4; ++j) acc[i][j] = (f32x4){0.f, 0.f, 0.f, 0.f};
    const bool wide = (MODE == 1) && (nt == NT - 1);
    f32x4 accx[4];
#pragma unroll
    for (int i = 0; i < 4; ++i) accx[i] = (f32x4){0.f, 0.f, 0.f, 0.f};
    const bf16_t* ap = A + (size_t)(m0 + lr) * LDA + lc;
    const bf16_t* bp = Bt + (size_t)(n0 + lr) * K + lc;
    constexpr int KT = K / 64;
#define GLDS_TILE(KT_, BUF_)                                                                       \
    {                                                                                              \
      const int k1_ = (KT_) * 64;                                                                  \
      const int acol_ = k1_ + ((MODE == 2 && k1_ >= 256) ? 512 : 0);                               \
      char* da_ = smem + (BUF_) * GBUF + w * 1024;                                                \
      _Pragma("unroll") for (int i = 0; i < 4; ++i) {                                              \
        __builtin_amdgcn_global_load_lds((const unsigned*)(gap + (size_t)i * 32 * LDA + acol_),    \
                                         (LAS unsigned*)(da_ + i * 4096), 16, 0, 0);               \
        __builtin_amdgcn_global_load_lds((const unsigned*)(gbp + (size_t)i * 32 * K + k1_),        \
                                         (LAS unsigned*)(da_ + 16384 + i * 4096), 16, 0, 0);       \
      }                                                                                            \
      if (wide && w < 2)                                                                           \
        __builtin_amdgcn_global_load_lds((const unsigned*)(gbp + (size_t)128 * K + k1_),           \
                                         (LAS unsigned*)(da_ + 32768), 16, 0, 0);                  \
    }
    const int rloc = w * 8 + (lane >> 3);
    const int gch = ((lane & 7) ^ ((rloc >> 1) & 7)) * 8;
    const bf16_t* gap = A + (size_t)(m0 + rloc) * LDA + gch;
    const bf16_t* gbp = Bt + (size_t)(n0 + rloc) * K + gch;
    GLDS_TILE(0, 0)
    for (int kt = 0; kt < KT; ++kt) {
      const int buf = kt & 1;
      asm volatile("s_waitcnt vmcnt(0) lgkmcnt(0)" ::: "memory");
      __builtin_amdgcn_s_barrier();
      asm volatile("" ::: "memory");
      __builtin_amdgcn_s_setprio(2);
      if (kt + 1 < KT) GLDS_TILE(kt + 1, buf ^ 1)
      const bf16_t* cA = (const bf16_t*)(smem + buf * GBUF);
      const bf16_t* cB = cA + 128 * 64;
      bf16x8 af0[4], bf0[4], af1[4], bf1[4];
#pragma unroll
      for (int i = 0; i < 4; ++i) af0[i] = *(const bf16x8*)(cA + (wm * 64 + i * 16 + l15) * 64 + rsw0);
#pragma unroll
      for (int j = 0; j < 4; ++j) bf0[j] = *(const bf16x8*)(cB + (wn * 64 + j * 16 + l15) * 64 + rsw0);
#pragma unroll
      for (int i = 0; i < 4; ++i) af1[i] = *(const bf16x8*)(cA + (wm * 64 + i * 16 + l15) * 64 + rsw1);
#pragma unroll
      for (int j = 0; j < 4; ++j) bf1[j] = *(const bf16x8*)(cB + (wn * 64 + j * 16 + l15) * 64 + rsw1);
      __builtin_amdgcn_s_setprio(0);
      __builtin_amdgcn_sched_barrier(0);
#pragma unroll
      for (int i = 0; i < 4; ++i)
#pragma unroll
        for (int j = 0; j < 4; ++j)
          acc[i][j] = __builtin_amdgcn_mfma_f32_16x16x32_bf16(bf0[j], af0[i], acc[i][j], 0, 0, 0);
#pragma unroll
      for (int i = 0; i < 4; ++i)
#pragma unroll
        for (int j = 0; j < 4; ++j)
          acc[i][j] = __builtin_amdgcn_mfma_f32_16x16x32_bf16(bf1[j], af1[i], acc[i][j], 0, 0, 0);
      if (MODE == 1 && wide && wn == 1) {
        const bf16x8 bx0 = *(const bf16x8*)(cB + (128 + l15) * 64 + rsw0), bx1 = *(const bf16x8*)(cB + (128 + l15) * 64 + rsw1);
#pragma unroll
        for (int i = 0; i < 4; ++i) {
          accx[i] = __builtin_amdgcn_mfma_f32_16x16x32_bf16(bx0, af0[i], accx[i], 0, 0, 0);
          accx[i] = __builtin_amdgcn_mfma_f32_16x16x32_bf16(bx1, af1[i], accx[i], 0, 0, 0);
        }
      }
    }
    asm volatile("s_waitcnt lgkmcnt(0)" ::: "memory");
    __builtin_amdgcn_s_barrier();
    asm volatile("" ::: "memory");
#undef GLDS_TILE
    if (MODE == 3) {
      float* gL = (float*)smem;
#pragma unroll
      for (int i = 0; i < 4; ++i)
#pragma unroll
        for (int j = 0; j < 2; ++j)
          *(float4*)(gL + (wm * 64 + i * 16 + l15) * 68 + wn * 32 + l4 * 8 + j * 4) = make_float4(acc[i][j][0], acc[i][j][1], acc[i][j][2], acc[i][j][3]);
      __syncthreads();
      bf16_t* hb = (bf16_t*)(p.ws + WS_H);
      bf16_t* sb = (bf16_t*)(p.ws + WS_SB) + (size_t)mt * 4 * 2 * DFF;
      const float* cw = p.in[22] + (size_t)l * 3 * DFF;
#pragma unroll
      for (int i = 0; i < 4; ++i) {
        const int row = wm * 64 + i * 16 + l15, m = m0 + row;
        const TokInfo ti = tokinfo(m);
        const bool defer = (row == 0 && ti.t >= 1) || (row == 1 && ti.t >= 2);
        const int slot = (row < 2) ? row : (row >= 126 ? row - 124 : -1);
        uint2 hq[2];
#pragma unroll
        for (int j = 0; j < 2; ++j) {
          const int fl = wn * 32 + l4 * 8 + j * 4, f = nt * 64 + fl;
          const f32x4 g0 = acc[i][j], vv = acc[i][j + 2];
          if (slot >= 0) {
            *(uint2*)(sb + (size_t)(slot * 2) * DFF + f) = make_uint2(pack2(g0[0], g0[1]), pack2(g0[2], g0[3]));
            if (slot < 2) *(uint2*)(sb + (size_t)(slot * 2 + 1) * DFF + f) = make_uint2(pack2(vv[0], vv[1]), pack2(vv[2], vv[3]));
          }
          if (ti.t >= ti.T - 2) {
            float* o = p.out + (ti.smp ? O_SFFN : O_PFFN) + ((size_t)(l * ti.NB + ti.seq) * 2 + (ti.t - (ti.T - 2))) * DFF + f;
            stnt4(o, make_float4(g0[0], g0[1], g0[2], g0[3]));
          }
          if (!defer) {
            float4 g1 = make_float4(0.f, 0.f, 0.f, 0.f), g2 = make_float4(0.f, 0.f, 0.f, 0.f);
            if (ti.t >= 1) g1 = *(const float4*)(gL + (row - 1) * 68 + fl);
            else if (ti.smp) g1 = *(const float4*)(p.in[8] + ((size_t)(l * 128 + ti.seq) * 2 + 1) * DFF + f);
            if (ti.t >= 2) g2 = *(const float4*)(gL + (row - 2) * 68 + fl);
            else if (ti.smp) g2 = *(const float4*)(p.in[8] + ((size_t)(l * 128 + ti.seq) * 2 + ti.t) * DFF + f);
            const float4 w0 = *(const float4*)(cw + f), w1 = *(const float4*)(cw + DFF + f), w2 = *(const float4*)(cw + 2 * DFF + f);
            const float h0 = siluf_(w0.x * g2.x + w1.x * g1.x + w2.x * g0[0]) * vv[0];
            const float h1 = siluf_(w0.y * g2.y + w1.y * g1.y + w2.y * g0[1]) * vv[1];
            const float h2 = siluf_(w0.z * g2.z + w1.z * g1.z + w2.z * g0[2]) * vv[2];
            const float h3 = siluf_(w0.w * g2.w + w1.w * g1.w + w2.w * g0[3]) * vv[3];
            hq[j] = make_uint2(pack2(h0, h1), pack2(h2, h3));
          }
        }
        if (!defer) *(u32x4*)(hb + (size_t)m * DFF + nt * 64 + wn * 32 + l4 * 8) = (u32x4){hq[0].x, hq[0].y, hq[1].x, hq[1].y};
      }
      __syncthreads();
      continue;
    }
    if (MODE == 1 && wide && wn == 1) {
      bf16_t* proj = (bf16_t*)(p.ws + WS_PROJ);
      float* gates = (float*)(p.ws + WS_GATES);
#pragma unroll
      for (int i = 0; i < 4; ++i) {
        const int m = m0 + wm * 64 + i * 16 + l15, n = n0 + 128 + l4 * 4;
        const f32x4 a = accx[i];
        *(uint2*)(proj + (size_t)m * DINS + n) = make_uint2(pack2(a[0], a[1]), pack2(a[2], a[3]));
        if (n >= 3848) *(float4*)(gates + (size_t)m * 16 + 8 + (n - 3848)) = make_float4(a[0], a[1], a[2], a[3]);
      }
    }
#pragma unroll
    for (int i = 0; i < 4; ++i) {
      const int m = m0 + wm * 64 + i * 16 + l15;
#pragma unroll
      for (int j = 0; j < 4; ++j) {
        const int n = n0 + wn * 64 + j * 16 + l4 * 4;
        f32x4 a = acc[i][j];
        if (MODE == 1) {
          if (n < DIN) {
            bf16_t* proj = (bf16_t*)(p.ws + WS_PROJ);
            *(uint2*)(proj + (size_t)m * DINS + n) = make_uint2(pack2(a[0], a[1]), pack2(a[2], a[3]));
            float* gates = (float*)(p.ws + WS_GATES);
            if (n >= 2816 && n < 2824) *(float4*)(gates + (size_t)m * 16 + (n - 2816)) = make_float4(a[0], a[1], a[2], a[3]);
            if (n >= 3848) *(float4*)(gates + (size_t)m * 16 + 8 + (n - 3848)) = make_float4(a[0], a[1], a[2], a[3]);
          }
        } else if (MODE == 3) {
          bf16_t* up = (bf16_t*)(p.ws + WS_UP);
          *(uint2*)(up + (size_t)m * DUP + n) = make_uint2(pack2(a[0], a[1]), pack2(a[2], a[3]));
          if (n < DFF) {
            TokInfo ti = tokinfo(m);
            if (ti.t >= ti.T - 2) {
              float* o = p.out + (ti.smp ? O_SFFN : O_PFFN) + ((size_t)(l * ti.NB + ti.seq) * 2 + (ti.t - (ti.T - 2))) * DFF + n;
              *(float4*)o = make_float4(a[0], a[1], a[2], a[3]);
            }
          }
        } else {
          const bf16_t* xb = (const bf16_t*)(p.ws + WS_XB);
          uint2 xv = *(const uint2*)(xb + (size_t)m * 1024 + n);
          float4 r;
          r.x = ALPHA_F * lo16(xv.x) + a[0];
          r.y = ALPHA_F * hi16(xv.x) + a[1];
          r.z = ALPHA_F * lo16(xv.y) + a[2];
          r.w = ALPHA_F * hi16(xv.y) + a[3];
          *(float4*)(p.out + O_Y + (size_t)m * 1024 + n) = r;
        }
      }
    }
  }
}

template <int CTRL> __device__ __forceinline__ float dppf1(float v) {
  return __int_as_float(__builtin_amdgcn_update_dpp(0, __float_as_int(v), CTRL, 0xf, 0xf, false));
}
__device__ __forceinline__ float wsum_fast(float v) {
  v += dppf1<0xB1>(v); v += dppf1<0x4E>(v); v += dppf1<0x141>(v); v += dppf1<0x140>(v);
  v += __shfl_xor(v, 16); v += __shfl_xor(v, 32);
  return v;
}
template <int RT, int SMP>
__device__ void e1_run(const Params& p, int l, int seq, int t0) {
  constexpr int T = SMP ? 8 : 2048, NB = SMP ? 128 : 8;
  bf16_t* proj = (bf16_t*)(p.ws + WS_PROJ);
  bf16_t* qkvp = (bf16_t*)(p.ws + WS_QKV);
  float* gates = (float*)(p.ws + WS_GATES);
  const float* conv_w = p.in[10] + l * 3 * 256;
  const float* gconv_w = p.in[11] + l * 4 * 1536;
  const int lane = otid() & 63;
  const int tokbase = SMP ? NPR + seq * 8 : seq * 2048;
  {
    const int ti = lane >> 2, h = lane & 3;
    if (ti < RT) {
      float* g = gates + (size_t)(tokbase + t0 + ti) * 16;
      const float ga = g[h], gb = g[4 + h], mi = g[8 + h], mf = g[12 + h];
      const float gg = -__expf(p.in[12][l * 4 + h]) * softplusf_(ga + p.in[13][l * 4 + h]);
      g[h] = __expf(gg);
      g[4 + h] = sigmoidf_(gb);
      g[8 + h] = mi + p.in[15][l * 4 + h];
      g[12 + h] = -softplusf_(-(mf + p.in[16][l * 4 + h]));
    }
  }
#pragma unroll 1
  for (int hb = 0; hb < RT / 8; ++hb) {
    const int c = lane * 4, th = t0 + hb * 8;
    float ah[10][4];
#pragma unroll
    for (int d = 0; d < 10; ++d) {
      const int tt = th - 2 + d;
      if (tt >= 0) {
        const bf16_t* r = proj + (size_t)(tokbase + tt) * DINS;
        const uint2 uc = *(const uint2*)(r + 256 + c), uh = *(const uint2*)(r + 512 + c);
        ah[d][0] = lo16(uc.x) * lo16(uh.x); ah[d][1] = hi16(uc.x) * hi16(uh.x);
        ah[d][2] = lo16(uc.y) * lo16(uh.y); ah[d][3] = hi16(uc.y) * hi16(uh.y);
      } else if (SMP) {
        const float4 v = *(const float4*)(p.in[2] + ((size_t)(l * 128 + seq) * 2 + (tt + 2)) * 256 + c);
        ah[d][0] = v.x; ah[d][1] = v.y; ah[d][2] = v.z; ah[d][3] = v.w;
      } else { ah[d][0] = ah[d][1] = ah[d][2] = ah[d][3] = 0.f; }
    }
    const float4 w0 = *(const float4*)(conv_w + c), w1 = *(const float4*)(conv_w + 256 + c), w2 = *(const float4*)(conv_w + 512 + c);
#pragma unroll
    for (int j = 0; j < 8; ++j) {
      bf16_t* row = proj + (size_t)(tokbase + th + j) * DINS;
      const uint2 ub = *(const uint2*)(row + c);
      const float y0 = lo16(ub.x) * (w0.x * ah[j][0] + w1.x * ah[j + 1][0] + w2.x * ah[j + 2][0]);
      const float y1 = hi16(ub.x) * (w0.y * ah[j][1] + w1.y * ah[j + 1][1] + w2.y * ah[j + 2][1]);
      const float y2 = lo16(ub.y) * (w0.z * ah[j][2] + w1.z * ah[j + 1][2] + w2.z * ah[j + 2][2]);
      const float y3 = hi16(ub.y) * (w0.w * ah[j][3] + w1.w * ah[j + 1][3] + w2.w * ah[j + 2][3]);
      *(uint2*)(row + c) = make_uint2(pack2(y0, y1), pack2(y2, y3));
      const int t = th + j;
      if (t >= T - 2) {
        float* o = p.out + (SMP ? O_SCONV : O_PCONV) + ((size_t)(l * NB + seq) * 2 + (t - (T - 2))) * 256 + c;
        stnt4(o, make_float4(ah[j + 2][0], ah[j + 2][1], ah[j + 2][2], ah[j + 2][3]));
      }
    }
  }
  float x0[RT + 3], x1[RT + 3], n0[RT + 3], n1[RT + 3];
  auto segload = [&](int seg, float (&a0)[RT + 3], float (&a1)[RT + 3]) {
    const int ch = seg * 128 + lane * 2;
#pragma unroll
    for (int d = 0; d < RT + 3; ++d) {
      const int tt = t0 - 3 + d;
      if (tt >= 0) {
        const unsigned u = *(const unsigned*)(proj + (size_t)(tokbase + tt) * DINS + 768 + ch);
        a0[d] = lo16(u); a1[d] = hi16(u);
      } else if (SMP) {
        const float2 v = *(const float2*)(p.in[3] + ((size_t)(l * 128 + seq) * 3 + (tt + 3)) * 1536 + ch);
        a0[d] = v.x; a1[d] = v.y;
      } else { a0[d] = 0.f; a1[d] = 0.f; }
    }
  };
  segload(0, x0, x1);
#pragma unroll 1
  for (int seg = 0; seg < 12; ++seg) {
    const int ch = seg * 128 + lane * 2;
    segload(seg < 11 ? seg + 1 : 11, n0, n1);
    float2 wv[4];
#pragma unroll
    for (int d = 0; d < 4; ++d) wv[d] = *(const float2*)(gconv_w + d * 1536 + ch);
#pragma unroll
    for (int j = 0; j < RT; ++j) {
      float c0 = 0.f, c1 = 0.f;
#pragma unroll
      for (int d = 0; d < 4; ++d) { c0 += wv[d].x * x0[j + d]; c1 += wv[d].y * x1[j + d]; }
      float s0 = siluf_(c0), s1 = siluf_(c1);
      if (seg < 8) {
        const float ss = wsum_fast(s0 * s0 + s1 * s1);
        float r = rsqrtf(ss + 1e-6f);
        if (seg < 4) r *= 0.08838834764831845f;
        s0 *= r; s1 *= r;
      }
      const int t = t0 + j;
      *(unsigned*)(qkvp + (size_t)(tokbase + t) * 1536 + ch) = pack2(s0, s1);
      if (t >= T - 3) {
        float* o = p.out + (SMP ? O_SGCONV : O_PGCONV) + ((size_t)(l * NB + seq) * 3 + (t - (T - 3))) * 1536 + ch;
        *(float2*)o = make_float2(x0[j + 3], x1[j + 3]);
      }
    }
#pragma unroll
    for (int d = 0; d < RT + 3; ++d) { x0[d] = n0[d]; x1[d] = n1[d]; }
  }
}
__device__ void e1_phase(const Params& p, int l) {
  const int gw = obid() * 4 + (otid() >> 6), nw = ogdim() * 4;
  for (int task = gw; task < 1152; task += nw) {
    if (task < 1024) e1_run<16, 0>(p, l, task >> 7, (task & 127) * 16);
    else e1_run<8, 1>(p, l, task - 1024, 0);
  }
}

template <int CTRL> __device__ __forceinline__ float dppf(float v) {
  return __int_as_float(__builtin_amdgcn_update_dpp(0, __float_as_int(v), CTRL, 0xf, 0xf, false));
}
__device__ __forceinline__ float red8(float v) {
  v += dppf<0xB1>(v); v += dppf<0x4E>(v); v += dppf<0x141>(v);
  return v;
}
__device__ __forceinline__ float red16(float v) {
  v += dppf<0xB1>(v); v += dppf<0x4E>(v); v += dppf<0x141>(v); v += dppf<0x140>(v);
  return v;
}

__device__ __forceinline__ float fma_(float a, float b, float c) { float d; asm("v_fma_f32 %0, %1, %2, %3" : "=v"(d) : "v"(a), "v"(b), "v"(c)); return d; }
__device__ __forceinline__ float exp_(float x) { float d; asm("v_exp_f32 %0, %1\n\ts_nop 1" : "=v"(d) : "v"(x * 1.4426950408889634f)); return d; }
__device__ __forceinline__ float mul_(float a, float b) { float d; asm("v_mul_f32 %0, %1, %2" : "=v"(d) : "v"(a), "v"(b)); return d; }
template <int NV>
__device__ void gdn_block(const Params& p, int l, int smp, int id, char* smem) {
  constexpr int NVQ = 8 / NV;
  constexpr int VB = 32 * NV;
  constexpr int BUF = 8192 + 16 * VB + 128;
  const int tid = otid(), lane = tid & 63, w = tid >> 6;
  const int kg = lane & 15, vi = lane >> 4;
  const int vq = id % NVQ, h = (id / NVQ) & 3, seq = id / (NVQ * 4);
  const int vloc = (w * 4 + vi) * NV;
  const int vcol = vq * 16 * NV + vloc;
  const int T = smp ? 8 : 2048, NB = smp ? 128 : 8;
  const int tok0 = smp ? NPR + seq * 8 : seq * 2048;
  const int tlast = tok0 + T - 1;
  const bf16_t* qkvp = (const bf16_t*)(p.ws + WS_QKV);
  bf16_t* proj = (bf16_t*)(p.ws + WS_PROJ);
  const float* gates = (const float*)(p.ws + WS_GATES);
  float S[NV][8];
  if (smp) {
    const float* s0 = p.in[4] + ((size_t)(l * 128 + seq) * 4 + h) * 16384 + (size_t)(kg * 8) * 128 + vcol;
#pragma unroll
    for (int j = 0; j < 8; ++j) {
      if (NV == 8) {
        float4 x = ldnt4(s0 + j * 128), y = ldnt4(s0 + j * 128 + 4);
        S[0][j] = x.x; S[1 % NV][j] = x.y; S[2 % NV][j] = x.z; S[3 % NV][j] = x.w;
        S[4 % NV][j] = y.x; S[5 % NV][j] = y.y; S[6 % NV][j] = y.z; S[7 % NV][j] = y.w;
      } else {
#pragma unroll
        for (int i = 0; i < NV; ++i) S[i][j] = s0[j * 128 + i];
      }
    }
  } else {
#pragma unroll
    for (int i = 0; i < NV; ++i)
#pragma unroll
      for (int j = 0; j < 8; ++j) S[i][j] = 0.f;
  }
  const int ltok = tid >> 4, lpart = tid & 15;
  const int vtok = tid / (2 * NV), vpart = tid % (2 * NV);
  const int gtok = (tid & 31) >> 1, gwhich = tid & 1;
  u32x4 rq, rk, rv = (u32x4){0u, 0u, 0u, 0u}; float rg = 0.f;
  const int nch = (T + 15) >> 4;
  auto gload = [&](int c) {
    int tk = tok0 + c * 16 + ltok; tk = tk > tlast ? tlast : tk;
    const bf16_t* r = qkvp + (size_t)tk * 1536 + h * 128 + lpart * 8;
    rq = *(const u32x4*)r; rk = *(const u32x4*)(r + 512);
    if (tid < 32 * NV) {
      int tv = tok0 + c * 16 + vtok; tv = tv > tlast ? tlast : tv;
      rv = *(const u32x4*)(qkvp + (size_t)tv * 1536 + 1024 + h * 128 + vq * 16 * NV + vpart * 8);
    }
    if (tid < 32) {
      int tg = tok0 + c * 16 + gtok; tg = tg > tlast ? tlast : tg;
      rg = gates[(size_t)tg * 16 + gwhich * 4 + h];
    }
  };
  auto lstore = [&](int b) {
    char* B = smem + b * BUF;
    *(u32x4*)(B + ltok * 256 + lpart * 16) = rq;
    *(u32x4*)(B + 4096 + ltok * 256 + lpart * 16) = rk;
    if (tid < 32 * NV) *(u32x4*)(B + 8192 + vtok * VB + vpart * 16) = rv;
    if (tid < 32) *(float*)(B + 8192 + 16 * VB + gtok * 8 + gwhich * 4) = rg;
  };
  __syncthreads();
  gload(0);
  lstore(0);
  __syncthreads();
  for (int c = 0; c < nch; ++c) {
    if (c + 1 < nch) gload(c + 1);
    const char* B = smem + (c & 1) * BUF;
    const int nt = (T - c * 16) < 16 ? (T - c * 16) : 16;
#pragma unroll 4
    for (int t = 0; t < nt; ++t) {
      const u32x4 cq = *(const u32x4*)(B + t * 256 + kg * 16), ck = *(const u32x4*)(B + 4096 + t * 256 + kg * 16);
      const float2 cab = *(const float2*)(B + 8192 + 16 * VB + t * 8);
      float vv[NV];
      if (NV == 8) {
        const u32x4 cv = *(const u32x4*)(B + 8192 + t * VB + vloc * 2);
        vv[0] = lo16(cv[0]); vv[1 % NV] = hi16(cv[0]); vv[2 % NV] = lo16(cv[1]); vv[3 % NV] = hi16(cv[1]);
        vv[4 % NV] = lo16(cv[2]); vv[5 % NV] = hi16(cv[2]); vv[6 % NV] = lo16(cv[3]); vv[7 % NV] = hi16(cv[3]);
      } else {
#pragma unroll
        for (int i = 0; i < NV; ++i) vv[i] = bf2f(*(const unsigned short*)(B + 8192 + t * VB + (vloc + i) * 2));
      }
      float kk[8], qq[8];
      kk[0] = lo16(ck[0]); kk[1] = hi16(ck[0]); kk[2] = lo16(ck[1]); kk[3] = hi16(ck[1]);
      kk[4] = lo16(ck[2]); kk[5] = hi16(ck[2]); kk[6] = lo16(ck[3]); kk[7] = hi16(ck[3]);
      qq[0] = lo16(cq[0]); qq[1] = hi16(cq[0]); qq[2] = lo16(cq[1]); qq[3] = hi16(cq[1]);
      qq[4] = lo16(cq[2]); qq[5] = hi16(cq[2]); qq[6] = lo16(cq[3]); qq[7] = hi16(cq[3]);
      const float a = cab.x, beta = cab.y;
      float ov[NV];
#pragma unroll
      for (int i = 0; i < NV; ++i) {
        float ks0 = S[i][0] * kk[0], ks1 = S[i][1] * kk[1];
#pragma unroll
        for (int j = 2; j < 8; j += 2) { ks0 += S[i][j] * kk[j]; ks1 += S[i][j + 1] * kk[j + 1]; }
        const float ks = red16(ks0 + ks1);
        const float u = beta * (vv[i] - a * ks);
#pragma unroll
        for (int j = 0; j < 8; ++j) S[i][j] = a * S[i][j] + kk[j] * u;
        float o0 = S[i][0] * qq[0], o1 = S[i][1] * qq[1];
#pragma unroll
        for (int j = 2; j < 8; j += 2) { o0 += S[i][j] * qq[j]; o1 += S[i][j + 1] * qq[j + 1]; }
        ov[i] = red16(o0 + o1);
      }
      if (kg == 0) {
        bf16_t* op = proj + (size_t)(tok0 + c * 16 + t) * DINS + 768 + h * 128 + vcol;
        if (NV == 8) {
          *(u32x4*)op = (u32x4){pack2(ov[0], ov[1 % NV]), pack2(ov[2 % NV], ov[3 % NV]), pack2(ov[4 % NV], ov[5 % NV]), pack2(ov[6 % NV], ov[7 % NV])};
        } else {
#pragma unroll
          for (int i = 0; i < NV; ++i) op[i] = (bf16_t)f2bf(ov[i]);
        }
      }
    }
    if (c + 1 < nch) lstore((c + 1) & 1);
    __syncthreads();
  }
  float* so = p.out + (smp ? O_SGDN : O_PGDN) + ((size_t)(l * NB + seq) * 4 + h) * 16384 + (size_t)(kg * 8) * 128 + vcol;
#pragma unroll
  for (int j = 0; j < 8; ++j) {
    if (NV == 8) {
      stnt4(so + j * 128, make_float4(S[0][j], S[1 % NV][j], S[2 % NV][j], S[3 % NV][j]));
      stnt4(so + j * 128 + 4, make_float4(S[4 % NV][j], S[5 % NV][j], S[6 % NV][j], S[7 % NV][j]));
    } else {
#pragma unroll
      for (int i = 0; i < NV; ++i) so[j * 128 + i] = S[i][j];
    }
  }
}

template <int NE>
__device__ void ml_block(const Params& p, int l, int smp, int id, char* smem) {
  constexpr int NEH = 2 / NE;
  constexpr int VB = 64 * NE;
  constexpr int BUF = 4096 + 16 * VB + 128;
  const int tid = otid(), lane = tid & 63, w = tid >> 6;
  const int dg = lane & 7, ei = lane >> 3;
  const int eh = id % NEH, h = (id / NEH) & 3, seq = id / (NEH * 4);
  const int eloc = (w * 8 + ei) * NE;
  const int ecol = eh * 32 * NE + eloc;
  const int T = smp ? 8 : 2048, NB = smp ? 128 : 8;
  const int tok0 = smp ? NPR + seq * 8 : seq * 2048;
  const int tlast = tok0 + T - 1;
  bf16_t* proj = (bf16_t*)(p.ws + WS_PROJ);
  const float* gates = (const float*)(p.ws + WS_GATES);
  float C[NE][8], nv[8], m;
  if (smp) {
    const float* c0 = p.in[5] + ((size_t)(l * 128 + seq) * 4 + h) * 4096 + (size_t)(dg * 8) * 64 + ecol;
    const float* n0 = p.in[6] + ((size_t)(l * 128 + seq) * 4 + h) * 64 + dg * 8;
#pragma unroll
    for (int j = 0; j < 8; ++j) {
#pragma unroll
      for (int i = 0; i < NE; ++i) C[i][j] = __builtin_nontemporal_load(c0 + j * 64 + i);
      nv[j] = n0[j];
    }
    m = p.in[7][(size_t)(l * 128 + seq) * 4 + h];
  } else {
#pragma unroll
    for (int j = 0; j < 8; ++j) {
#pragma unroll
      for (int i = 0; i < NE; ++i) C[i][j] = 0.f;
      nv[j] = 0.f;
    }
    m = 0.f;
  }
  const int ltok = (tid & 127) >> 3, lpart = tid & 7, lk = tid >> 7;
  const int vtok = tid / (4 * NE), vpart = tid % (4 * NE);
  const int gtok = (tid & 31) >> 1, gwhich = tid & 1;
  u32x4 rqk, rv = (u32x4){0u, 0u, 0u, 0u}; float rg = 0.f;
  const int nch = (T + 15) >> 4;
  auto gload = [&](int c) {
    int tk = tok0 + c * 16 + ltok; tk = tk > tlast ? tlast : tk;
    rqk = *(const u32x4*)(proj + (size_t)tk * DINS + 2824 + lk * 256 + h * 64 + lpart * 8);
    if (tid < 64 * NE) {
      int tv = tok0 + c * 16 + vtok; tv = tv > tlast ? tlast : tv;
      rv = *(const u32x4*)(proj + (size_t)tv * DINS + 3336 + h * 64 + eh * 32 * NE + vpart * 8);
    }
    if (tid < 32) {
      int tg = tok0 + c * 16 + gtok; tg = tg > tlast ? tlast : tg;
      rg = gates[(size_t)tg * 16 + 8 + gwhich * 4 + h];
    }
  };
  auto lstore = [&](int b) {
    char* B = smem + b * BUF;
    *(u32x4*)(B + lk * 2048 + ltok * 128 + lpart * 16) = rqk;
    if (tid < 64 * NE) *(u32x4*)(B + 4096 + vtok * VB + vpart * 16) = rv;
    if (tid < 32) *(float*)(B + 4096 + 16 * VB + gtok * 8 + gwhich * 4) = rg;
  };
  __syncthreads();
  gload(0);
  lstore(0);
  __syncthreads();
  for (int c = 0; c < nch; ++c) {
    if (c + 1 < nch) gload(c + 1);
    const char* B = smem + (c & 1) * BUF;
    const int nt = (T - c * 16) < 16 ? (T - c * 16) : 16;
#pragma unroll 4
    for (int t = 0; t < nt; ++t) {
      const u32x4 cq = *(const u32x4*)(B + t * 128 + dg * 16), ck = *(const u32x4*)(B + 2048 + t * 128 + dg * 16);
      const float2 cg = *(const float2*)(B + 4096 + 16 * VB + t * 8);
      float vv[NE];
      if (NE == 2) {
        const unsigned cv = *(const unsigned*)(B + 4096 + t * VB + eloc * 2);
        vv[0] = lo16(cv); vv[1 % NE] = hi16(cv);
      } else {
        vv[0] = bf2f(*(const unsigned short*)(B + 4096 + t * VB + eloc * 2));
      }
      float qq[8], kk[8];
      qq[0] = lo16(cq[0]); qq[1] = hi16(cq[0]); qq[2] = lo16(cq[1]); qq[3] = hi16(cq[1]);
      qq[4] = lo16(cq[2]); qq[5] = hi16(cq[2]); qq[6] = lo16(cq[3]); qq[7] = hi16(cq[3]);
      kk[0] = lo16(ck[0]); kk[1] = hi16(ck[0]); kk[2] = lo16(ck[1]); kk[3] = hi16(ck[1]);
      kk[4] = lo16(ck[2]); kk[5] = hi16(ck[2]); kk[6] = lo16(ck[3]); kk[7] = hi16(ck[3]);
      const float ig = cg.x, lf = cg.y;
      const float mn = fmaxf(lf + m, ig);
      const float dc = __expf(lf + m - mn);
      const float wk = __expf(ig - mn) * 0.125f;
      float qn0 = 0.f, qn1 = 0.f;
#pragma unroll
      for (int j = 0; j < 8; j += 2) {
        nv[j] = dc * nv[j] + kk[j] * wk; nv[j + 1] = dc * nv[j + 1] + kk[j + 1] * wk;
        qn0 += qq[j] * nv[j]; qn1 += qq[j + 1] * nv[j + 1];
      }
      const float qn = red8(qn0 + qn1);
      const float rden = __builtin_amdgcn_rcpf(fmaxf(fabsf(qn), __expf(-mn)));
      float hv[NE];
#pragma unroll
      for (int i = 0; i < NE; ++i) {
        const float wkv = wk * vv[i];
        float n0 = 0.f, n1 = 0.f;
#pragma unroll
        for (int j = 0; j < 8; j += 2) {
          C[i][j] = dc * C[i][j] + kk[j] * wkv; C[i][j + 1] = dc * C[i][j + 1] + kk[j + 1] * wkv;
          n0 += qq[j] * C[i][j]; n1 += qq[j + 1] * C[i][j + 1];
        }
        hv[i] = red8(n0 + n1) * rden;
      }
      if (dg == 0) {
        bf16_t* op = proj + (size_t)(tok0 + c * 16 + t) * DINS + 1280 + h * 64 + ecol;
        if (NE == 2) *(unsigned*)op = pack2(hv[0], hv[1 % NE]);
        else op[0] = (bf16_t)f2bf(hv[0]);
      }
      m = mn;
    }
    if (c + 1 < nch) lstore((c + 1) & 1);
    __syncthreads();
  }
  float* co = p.out + (smp ? O_SC : O_PC) + ((size_t)(l * NB + seq) * 4 + h) * 4096 + (size_t)(dg * 8) * 64 + ecol;
#pragma unroll
  for (int j = 0; j < 8; ++j)
#pragma unroll
    for (int i = 0; i < NE; ++i) __builtin_nontemporal_store(C[i][j], co + j * 64 + i);
  if (eh == 0 && w == 0 && ei == 0) {
    float* no = p.out + (smp ? O_SN : O_PN) + ((size_t)(l * NB + seq) * 4 + h) * 64 + dg * 8;
#pragma unroll
    for (int j = 0; j < 8; ++j) no[j] = nv[j];
    if (dg == 0) p.out[(smp ? O_SM : O_PM) + (size_t)(l * NB + seq) * 4 + h] = m;
  }
}

#define YREC_ELEMS 12288
template <int MF, int NF, int KS>
__device__ __forceinline__ void mm_lds(f32x4 (&acc)[MF][NF], const bf16_t* A, int lda, const bf16_t* Bt, int ldb, int l15, int l4) {
#pragma unroll
  for (int ks = 0; ks < KS; ++ks) {
    bf16x8 a[MF], b[NF];
#pragma unroll
    for (int i = 0; i < MF; ++i) a[i] = *(const bf16x8*)(A + (i * 16 + l15) * lda + ks * 32 + l4 * 8);
#pragma unroll
    for (int j = 0; j < NF; ++j) b[j] = *(const bf16x8*)(Bt + (j * 16 + l15) * ldb + ks * 32 + l4 * 8);
#pragma unroll
    for (int i = 0; i < MF; ++i)
#pragma unroll
      for (int j = 0; j < NF; ++j) acc[i][j] = __builtin_amdgcn_mfma_f32_16x16x32_bf16(b[j], a[i], acc[i][j], 0, 0, 0);
  }
}

template <int II>
__device__ __forceinline__ void solve_rows(float (&wv)[64], const float* sM, const float* sF, const bf16_t* src) {
  if constexpr (II < 64) {
    float s0 = sF[II] * bf2f(src[II * 136]), s1 = 0.f, s2 = 0.f, s3 = 0.f;
#pragma unroll
    for (int j4 = 0; j4 < (II + 3) / 4; ++j4) {
      const float4 m = *(const float4*)(sM + II * 68 + j4 * 4);
      if (j4 * 4 + 0 < II) s0 -= m.x * wv[j4 * 4 + 0];
      if (j4 * 4 + 1 < II) s1 -= m.y * wv[j4 * 4 + 1];
      if (j4 * 4 + 2 < II) s2 -= m.z * wv[j4 * 4 + 2];
      if (j4 * 4 + 3 < II) s3 -= m.w * wv[j4 * 4 + 3];
    }
    wv[II] = (s0 + s1) + (s2 + s3);
    __builtin_amdgcn_sched_barrier(0);
    solve_rows<II + 1>(wv, sM, sF, src);
  }
}
template <int II>
__device__ __forceinline__ void store_rows(const float (&wv)[64], bf16_t* dst, float sgn) {
  if constexpr (II < 64) {
    dst[(size_t)II * 1536] = (bf16_t)f2bf(sgn * wv[II]);
    store_rows<II + 1>(wv, dst, sgn);
  }
}

__device__ void gdn_k1(const Params& p, int l, int unit, char* smem) {
  const int tid = otid(), lane = tid & 63, w = tid >> 6, l15 = lane & 15, l4 = lane >> 4;
  const int c = unit & 31, h = (unit >> 5) & 3, b = unit >> 7;
  const int tok0 = b * 2048 + c * 64;
  bf16_t* qkvp = (bf16_t*)(p.ws + WS_QKV);
  const float* gates = (const float*)(p.ws + WS_GATES);
  bf16_t* yrec = (bf16_t*)(p.out + O_Y) + (size_t)unit * YREC_ELEMS;
  bf16_t* sQ = (bf16_t*)smem;
  bf16_t* sK = (bf16_t*)(smem + 17408);
  bf16_t* sV = (bf16_t*)(smem + 34816);
  float* sG = (float*)(smem + 52224);
  float* sBe = (float*)(smem + 52480);
  float* sg = (float*)(smem + 52736);
  float* sF = (float*)(smem + 52992);
  float* sM = (float*)smem;
  __syncthreads();
#pragma unroll
  for (int x = 0; x < 4; ++x) {
    const int ch = tid + 256 * x, r = ch >> 4, cc = (ch & 15) * 8;
    const bf16_t* g = qkvp + (size_t)(tok0 + r) * 1536 + h * 128 + cc;
    *(u32x4*)(sQ + r * 136 + cc) = *(const u32x4*)g;
    *(u32x4*)(sK + r * 136 + cc) = *(const u32x4*)(g + 512);
    *(u32x4*)(sV + r * 136 + cc) = *(const u32x4*)(g + 1024);
  }
  if (tid < 64) {
    sg[tid] = __logf(gates[(size_t)(tok0 + tid) * 16 + h]);
    sBe[tid] = gates[(size_t)(tok0 + tid) * 16 + 4 + h];
  }
  __syncthreads();
  if (tid < 64) { float s = 0.f; for (int j = 0; j <= tid; ++j) s += sg[j]; sG[tid] = s; sF[tid] = sBe[tid]; sF[64 + tid] = sBe[tid] * __expf(s); }
  __syncthreads();
  f32x4 kk[1][4], qk[1][4];
#pragma unroll
  for (int j = 0; j < 4; ++j) { kk[0][j] = (f32x4){0.f, 0.f, 0.f, 0.f}; qk[0][j] = (f32x4){0.f, 0.f, 0.f, 0.f}; }
  mm_lds<1, 4, 4>(kk, sK + 16 * w * 136, 136, sK, 136, l15, l4);
  mm_lds<1, 4, 4>(qk, sQ + 16 * w * 136, 136, sK, 136, l15, l4);
  const int i = 16 * w + l15;
  const float Gi = sG[i], bi = sBe[i], G63 = sG[63];
#pragma unroll
  for (int nf = 0; nf < 4; ++nf) {
    float qv[4];
#pragma unroll
    for (int r = 0; r < 4; ++r) {
      const int j = 16 * nf + 4 * l4 + r;
      const float dec = (j <= i) ? __expf(Gi - sG[j]) : 0.f;
      kk[0][nf][r] = (j < i) ? bi * kk[0][nf][r] * dec : 0.f;
      qv[r] = qk[0][nf][r] * dec;
    }
    *(uint2*)(yrec + i * 64 + 16 * nf + 4 * l4) = make_uint2(pack2(qv[0], qv[1]), pack2(qv[2], qv[3]));
  }
  {
    const int r = tid >> 2, c0 = (tid & 3) * 32;
    const float e = __expf(sG[r]);
    bf16_t* dst = qkvp + (size_t)(tok0 + r) * 1536 + h * 128 + c0;
#pragma unroll
    for (int x = 0; x < 4; ++x) {
      u32x4 u = *(const u32x4*)(sQ + r * 136 + c0 + x * 8);
      u32x4 o;
#pragma unroll
      for (int y = 0; y < 4; ++y) o[y] = pack2(lo16(u[y]) * e, hi16(u[y]) * e);
      *(u32x4*)(dst + x * 8) = o;
    }
    const int kc = tid & 127, ih = tid >> 7;
#pragma unroll
    for (int x = 0; x < 4; ++x) {
      const int i0 = ih * 32 + x * 8;
      float v[8];
#pragma unroll
      for (int y = 0; y < 8; ++y) v[y] = bf2f(sK[(i0 + y) * 136 + kc]) * __expf(G63 - sG[i0 + y]);
      *(u32x4*)(yrec + 4096 + kc * 64 + i0) = (u32x4){pack2(v[0], v[1]), pack2(v[2], v[3]), pack2(v[4], v[5]), pack2(v[6], v[7])};
    }
  }
  __syncthreads();
#pragma unroll
  for (int nf = 0; nf < 4; ++nf)
    *(float4*)(sM + i * 68 + 16 * nf + 4 * l4) = make_float4(kk[0][nf][0], kk[0][nf][1], kk[0][nf][2], kk[0][nf][3]);
  __syncthreads();
  {
    float wv[64];
    const int col = tid & 127;
    const bool isv = tid < 128;
    solve_rows<0>(wv, sM, sF + (isv ? 0 : 64), (isv ? sV : sK) + col);
    bf16_t* dst = qkvp + (size_t)tok0 * 1536 + (isv ? 1024 : 512) + h * 128 + col;
    const float sgn = isv ? 1.f : -1.f;
    store_rows<0>(wv, dst, sgn);
  }
  if (tid == 0) ((float*)(p.ws + WS_EL))[unit] = __expf(G63);
}

__device__ void gdn_k2(const Params& p, int l, int task, char* smem) {
  const int tid = otid(), lane = tid & 63, w = tid >> 6, l15 = lane & 15, l4 = lane >> 4;
  const int vh = task & 1, sh = task >> 1, h = sh & 3, b = sh >> 2;
  const int vcol = vh * 64 + 16 * w + l15;
  const bf16_t* qkvp = (const bf16_t*)(p.ws + WS_QKV);
  bf16_t* proj = (bf16_t*)(p.ws + WS_PROJ);
  const float* EL = (const float*)(p.ws + WS_EL);
  bf16_t* sWk = (bf16_t*)smem;
  bf16_t* sQg = (bf16_t*)(smem + 17408);
  bf16_t* sQK = (bf16_t*)(smem + 34816);
  bf16_t* sKd = (bf16_t*)(smem + 44032);
  f32x4 S[8];
#pragma unroll
  for (int nf = 0; nf < 8; ++nf) S[nf] = (f32x4){0.f, 0.f, 0.f, 0.f};
  u32x4 st[14];
  unsigned wvp[16];
  auto gload = [&](int c) {
    const int tok0 = b * 2048 + c * 64;
    const bf16_t* yrec = (const bf16_t*)(p.out + O_Y) + (size_t)((b * 4 + h) * 32 + c) * YREC_ELEMS;
#pragma unroll
    for (int x = 0; x < 4; ++x) {
      const int ch = tid + 256 * x, r = ch >> 4, cc = (ch & 15) * 8;
      const bf16_t* g = qkvp + (size_t)(tok0 + r) * 1536 + h * 128 + cc;
      st[x] = *(const u32x4*)(g + 512);
      st[4 + x] = *(const u32x4*)g;
      st[10 + x] = *(const u32x4*)(yrec + 4096 + ch * 8);
    }
#pragma unroll
    for (int x = 0; x < 2; ++x) st[8 + x] = *(const u32x4*)(yrec + (tid + 256 * x) * 8);
#pragma unroll
    for (int nf = 0; nf < 4; ++nf) {
      const bf16_t* g = qkvp + (size_t)(tok0 + 16 * nf + 4 * l4) * 1536 + 1024 + h * 128 + vcol;
#pragma unroll
      for (int r = 0; r < 4; ++r) wvp[nf * 4 + r] = g[(size_t)r * 1536];
    }
  };
  auto lstore = [&]() {
#pragma unroll
    for (int x = 0; x < 4; ++x) {
      const int ch = tid + 256 * x, r = ch >> 4, cc = (ch & 15) * 8;
      *(u32x4*)(sWk + r * 136 + cc) = st[x];
      *(u32x4*)(sQg + r * 136 + cc) = st[4 + x];
      *(u32x4*)(sKd + (ch >> 3) * 72 + (ch & 7) * 8) = st[10 + x];
    }
#pragma unroll
    for (int x = 0; x < 2; ++x) { const int ch = tid + 256 * x; *(u32x4*)(sQK + (ch >> 3) * 72 + (ch & 7) * 8) = st[8 + x]; }
  };
  auto bperm = [&](const bf16_t* Bt, int ld, int row, int s) -> bf16x8 {
    const uint2 lo = *(const uint2*)(Bt + row * ld + 32 * s + 4 * l4);
    const uint2 hi = *(const uint2*)(Bt + row * ld + 32 * s + 16 + 4 * l4);
    u32x4 u = (u32x4){lo.x, lo.y, hi.x, hi.y};
    return __builtin_bit_cast(bf16x8, u);
  };
  auto afrag = [&](const f32x4& x0, const f32x4& x1) -> bf16x8 {
    u32x4 u = (u32x4){pack2(x0[0], x0[1]), pack2(x0[2], x0[3]), pack2(x1[0], x1[1]), pack2(x1[2], x1[3])};
    return __builtin_bit_cast(bf16x8, u);
  };
  __syncthreads();
  gload(0);
  for (int c = 0; c < 32; ++c) {
    const int tok0 = b * 2048 + c * 64;
    lstore();
    f32x4 uT[4], oT[4];
#pragma unroll
    for (int nf = 0; nf < 4; ++nf) {
#pragma unroll
      for (int r = 0; r < 4; ++r) uT[nf][r] = bf2f(wvp[nf * 4 + r]);
      oT[nf] = (f32x4){0.f, 0.f, 0.f, 0.f};
    }
    __syncthreads();
    if (c + 1 < 32) gload(c + 1);
    const float eL = EL[(b * 4 + h) * 32 + c];
#pragma unroll
    for (int s = 0; s < 4; ++s) {
      const bf16x8 aS = afrag(S[2 * s], S[2 * s + 1]);
#pragma unroll
      for (int nf = 0; nf < 4; ++nf) {
        const bf16x8 bw = bperm(sWk, 136, 16 * nf + l15, s), bq = bperm(sQg, 136, 16 * nf + l15, s);
        uT[nf] = __builtin_amdgcn_mfma_f32_16x16x32_bf16(bw, aS, uT[nf], 0, 0, 0);
        oT[nf] = __builtin_amdgcn_mfma_f32_16x16x32_bf16(bq, aS, oT[nf], 0, 0, 0);
      }
    }
#pragma unroll
    for (int nf = 0; nf < 8; ++nf) S[nf] *= eL;
#pragma unroll
    for (int s = 0; s < 2; ++s) {
      const bf16x8 aU = afrag(uT[2 * s], uT[2 * s + 1]);
#pragma unroll
      for (int nf = 0; nf < 4; ++nf) {
        const bf16x8 bq = bperm(sQK, 72, 16 * nf + l15, s);
        oT[nf] = __builtin_amdgcn_mfma_f32_16x16x32_bf16(bq, aU, oT[nf], 0, 0, 0);
      }
#pragma unroll
      for (int nf = 0; nf < 8; ++nf) {
        const bf16x8 bk = bperm(sKd, 72, 16 * nf + l15, s);
        S[nf] = __builtin_amdgcn_mfma_f32_16x16x32_bf16(bk, aU, S[nf], 0, 0, 0);
      }
    }
#pragma unroll
    for (int nf = 0; nf < 4; ++nf) {
      bf16_t* g = proj + (size_t)(tok0 + 16 * nf + 4 * l4) * DINS + 768 + h * 128 + vcol;
#pragma unroll
      for (int r = 0; r < 4; ++r) g[(size_t)r * DINS] = (bf16_t)f2bf(oT[nf][r]);
    }
    __syncthreads();
  }
  float* so = p.out + O_PGDN + ((size_t)(l * 8 + b) * 4 + h) * 16384;
#pragma unroll
  for (int nf = 0; nf < 8; ++nf)
#pragma unroll
    for (int r = 0; r < 4; ++r) __builtin_nontemporal_store(S[nf][r], so + (size_t)(16 * nf + 4 * l4 + r) * 128 + vcol);
}

#define MLREC_BF (1024ull * YREC_ELEMS)
#define MLREC_F  12582912ull
__device__ void ml_k1(const Params& p, int l, int unit, char* smem) {
  const int tid = otid(), lane = tid & 63, w = tid >> 6, l15 = lane & 15, l4 = lane >> 4;
  const int c = unit & 31, h = (unit >> 5) & 3, b = unit >> 7;
  const int tok0 = b * 2048 + c * 64;
  const bf16_t* proj = (const bf16_t*)(p.ws + WS_PROJ);
  const float* gates = (const float*)(p.ws + WS_GATES);
  bf16_t* rec = (bf16_t*)(p.out + O_Y) + MLREC_BF + (size_t)unit * YREC_ELEMS;
  float* recf = p.out + O_Y + MLREC_F + (size_t)unit * 320;
  bf16_t* sQ = (bf16_t*)smem;
  bf16_t* sK = (bf16_t*)(smem + 9216);
  bf16_t* sV = (bf16_t*)(smem + 18432);
  float* sA = (float*)(smem + 27648);
  float* slf = (float*)(smem + 27904);
  float* sig = (float*)(smem + 28160);
  float* sCF = (float*)(smem + 28416);
  float* sKS = (float*)(smem + 28672);
  __syncthreads();
#pragma unroll
  for (int x = 0; x < 2; ++x) {
    const int ch = tid + 256 * x, r = ch >> 3, cc = (ch & 7) * 8;
    const bf16_t* g = proj + (size_t)(tok0 + r) * DINS + h * 64 + cc;
    *(u32x4*)(sQ + r * 72 + cc) = *(const u32x4*)(g + 2824);
    *(u32x4*)(sK + r * 72 + cc) = *(const u32x4*)(g + 3080);
    *(u32x4*)(sV + r * 72 + cc) = *(const u32x4*)(g + 3336);
  }
  if (tid < 64) {
    sig[tid] = gates[(size_t)(tok0 + tid) * 16 + 8 + h];
    slf[tid] = gates[(size_t)(tok0 + tid) * 16 + 12 + h];
  }
  __syncthreads();
  if (tid < 64) {
    float F = 0.f;
    for (int j = 0; j <= tid; ++j) F += slf[j];
    sA[tid] = sig[tid] - F;
    recf[tid] = F;
  }
  __syncthreads();
  if (tid < 64) {
    float bm = -3.0e38f, B = -3.0e38f;
    for (int j = 0; j < 64; ++j) { const float a = sA[j]; B = fmaxf(B, a); if (j <= tid) bm = fmaxf(bm, a); }
    recf[64 + tid] = bm;
    sCF[tid] = 0.125f * __expf(sA[tid] - B);
    if (tid == 0) recf[256] = B;
  }
  __syncthreads();
  f32x4 qk[1][4];
#pragma unroll
  for (int j = 0; j < 4; ++j) qk[0][j] = (f32x4){0.f, 0.f, 0.f, 0.f};
  mm_lds<1, 4, 2>(qk, sQ + 16 * w * 72, 72, sK, 72, l15, l4);
  {
    const int i = 16 * w + l15;
    float rsum = 0.f;
#pragma unroll
    for (int nf = 0; nf < 4; ++nf) {
      float pv[4];
#pragma unroll
      for (int r = 0; r < 4; ++r) {
        const int j = 16 * nf + 4 * l4 + r;
        pv[r] = (j <= i) ? qk[0][nf][r] * sCF[j] : 0.f;
        rsum += pv[r];
      }
      *(uint2*)(rec + i * 64 + 16 * nf + 4 * l4) = make_uint2(pack2(pv[0], pv[1]), pack2(pv[2], pv[3]));
    }
    rsum += __shfl_xor(rsum, 16); rsum += __shfl_xor(rsum, 32);
    if (l4 == 0) recf[128 + i] = rsum;
  }
  {
    const int d = tid & 63, jq = tid >> 6;
    float ks = 0.f;
#pragma unroll
    for (int x = 0; x < 2; ++x) {
      const int j0 = jq * 16 + x * 8;
      float kv[8]; unsigned vv[8];
#pragma unroll
      for (int y = 0; y < 8; ++y) { kv[y] = bf2f(sK[(j0 + y) * 72 + d]) * sCF[j0 + y]; ks += kv[y]; vv[y] = sV[(j0 + y) * 72 + d]; }
      *(u32x4*)(rec + 4096 + d * 64 + j0) = (u32x4){pack2(kv[0], kv[1]), pack2(kv[2], kv[3]), pack2(kv[4], kv[5]), pack2(kv[6], kv[7])};
      *(u32x4*)(rec + 8192 + d * 64 + j0) = (u32x4){vv[0] | (vv[1] << 16), vv[2] | (vv[3] << 16), vv[4] | (vv[5] << 16), vv[6] | (vv[7] << 16)};
    }
    sKS[jq * 64 + d] = ks;
  }
  __syncthreads();
  if (tid < 64) recf[192 + tid] = sKS[tid] + sKS[64 + tid] + sKS[128 + tid] + sKS[192 + tid];
}

__device__ void ml_k2(const Params& p, int l, int sh, char* smem) {
  const int tid = otid(), lane = tid & 63, w = tid >> 6, l15 = lane & 15, l4 = lane >> 4;
  const int h = sh & 3, b = sh >> 2;
  const int ecol = 16 * w + l15;
  bf16_t* proj = (bf16_t*)(p.ws + WS_PROJ);
  bf16_t* sQ = (bf16_t*)smem;
  bf16_t* sP = (bf16_t*)(smem + 9216);
  bf16_t* sKc = (bf16_t*)(smem + 18432);
  bf16_t* sVt = (bf16_t*)(smem + 27648);
  float* wn = (float*)(smem + 36864 + w * 1024);
  float* cw1 = wn + 64;
  float* cw2 = wn + 128;
  f32x4 S[4];
#pragma unroll
  for (int nf = 0; nf < 4; ++nf) S[nf] = (f32x4){0.f, 0.f, 0.f, 0.f};
  float nd = 0.f, m = 0.f;
  u32x4 st[8];
  float rF, rb, rrs, rks, rB, rF63;
  auto gload = [&](int c) {
    const int tok0 = b * 2048 + c * 64;
    const int unit = (b * 4 + h) * 32 + c;
    const bf16_t* rec = (const bf16_t*)(p.out + O_Y) + MLREC_BF + (size_t)unit * YREC_ELEMS;
    const float* recf = p.out + O_Y + MLREC_F + (size_t)unit * 320;
#pragma unroll
    for (int x = 0; x < 2; ++x) {
      const int ch = tid + 256 * x, r = ch >> 3, cc = (ch & 7) * 8;
      st[x] = *(const u32x4*)(proj + (size_t)(tok0 + r) * DINS + 2824 + h * 64 + cc);
      st[2 + x] = *(const u32x4*)(rec + ch * 8);
      st[4 + x] = *(const u32x4*)(rec + 4096 + ch * 8);
      st[6 + x] = *(const u32x4*)(rec + 8192 + ch * 8);
    }
    rF = recf[lane]; rb = recf[64 + lane]; rrs = recf[128 + lane]; rks = recf[192 + lane]; rB = recf[256]; rF63 = recf[63];
  };
  auto lstore = [&]() {
#pragma unroll
    for (int x = 0; x < 2; ++x) {
      const int ch = tid + 256 * x, o = (ch >> 3) * 72 + (ch & 7) * 8;
      *(u32x4*)(sQ + o) = st[x];
      *(u32x4*)(sP + o) = st[2 + x];
      *(u32x4*)(sKc + o) = st[4 + x];
      *(u32x4*)(sVt + o) = st[6 + x];
    }
  };
  auto bperm = [&](const bf16_t* Bt, int ld, int row, int s) -> bf16x8 {
    const uint2 lo = *(const uint2*)(Bt + row * ld + 32 * s + 4 * l4);
    const uint2 hi = *(const uint2*)(Bt + row * ld + 32 * s + 16 + 4 * l4);
    u32x4 u = (u32x4){lo.x, lo.y, hi.x, hi.y};
    return __builtin_bit_cast(bf16x8, u);
  };
  auto afrag = [&](const f32x4& x0, const f32x4& x1) -> bf16x8 {
    u32x4 u = (u32x4){pack2(x0[0], x0[1]), pack2(x0[2], x0[3]), pack2(x1[0], x1[1]), pack2(x1[2], x1[3])};
    return __builtin_bit_cast(bf16x8, u);
  };
  __syncthreads();
  gload(0);
  for (int c = 0; c < 32; ++c) {
    const int tok0 = b * 2048 + c * 64;
    lstore();
    const float Fi = rF, bi = rb, rsi = rrs, ksd = rks, B = rB, F63 = rF63;
    __syncthreads();
    if (c + 1 < 32) gload(c + 1);
    wn[lane] = nd;
    const float mv = fmaxf(m, bi);
    const float wI = __expf(m - mv), rf = __expf(B - mv);
    float qdn = 0.f;
#pragma unroll
    for (int x = 0; x < 8; ++x) {
      const u32x4 qv = *(const u32x4*)(sQ + lane * 72 + x * 8);
      const float4 n0 = *(const float4*)(wn + x * 8), n1 = *(const float4*)(wn + x * 8 + 4);
      qdn += lo16(qv[0]) * n0.x + hi16(qv[0]) * n0.y + lo16(qv[1]) * n0.z + hi16(qv[1]) * n0.w
           + lo16(qv[2]) * n1.x + hi16(qv[2]) * n1.y + lo16(qv[3]) * n1.z + hi16(qv[3]) * n1.w;
    }
    const float qn = wI * qdn + rf * rsi;
    const float rden = __builtin_amdgcn_rcpf(fmaxf(fabsf(qn), __expf(-(Fi + mv))));
    cw1[lane] = wI * rden;
    cw2[lane] = rf * rden;
    f32x4 X1[4], X2[1][4], T[1][4];
#pragma unroll
    for (int nf = 0; nf < 4; ++nf) { X1[nf] = (f32x4){0.f, 0.f, 0.f, 0.f}; X2[0][nf] = (f32x4){0.f, 0.f, 0.f, 0.f}; T[0][nf] = (f32x4){0.f, 0.f, 0.f, 0.f}; }
#pragma unroll
    for (int s = 0; s < 2; ++s) {
      const bf16x8 aS = afrag(S[2 * s], S[2 * s + 1]);
#pragma unroll
      for (int nf = 0; nf < 4; ++nf) X1[nf] = __builtin_amdgcn_mfma_f32_16x16x32_bf16(bperm(sQ, 72, 16 * nf + l15, s), aS, X1[nf], 0, 0, 0);
    }
    mm_lds<1, 4, 2>(X2, sVt + 16 * w * 72, 72, sP, 72, l15, l4);
    mm_lds<1, 4, 2>(T, sVt + 16 * w * 72, 72, sKc, 72, l15, l4);
#pragma unroll
    for (int nf = 0; nf < 4; ++nf) {
      const float4 c1 = *(const float4*)(cw1 + 16 * nf + 4 * l4), c2 = *(const float4*)(cw2 + 16 * nf + 4 * l4);
      bf16_t* g = proj + (size_t)(tok0 + 16 * nf + 4 * l4) * DINS + 1280 + h * 64 + ecol;
      g[0] = (bf16_t)f2bf(c1.x * X1[nf][0] + c2.x * X2[0][nf][0]);
      g[(size_t)DINS] = (bf16_t)f2bf(c1.y * X1[nf][1] + c2.y * X2[0][nf][1]);
      g[(size_t)2 * DINS] = (bf16_t)f2bf(c1.z * X1[nf][2] + c2.z * X2[0][nf][2]);
      g[(size_t)3 * DINS] = (bf16_t)f2bf(c1.w * X1[nf][3] + c2.w * X2[0][nf][3]);
    }
    const float mB = fmaxf(m, B);
    const float dc = __expf(m - mB), fac = __expf(B - mB);
#pragma unroll
    for (int nf = 0; nf < 4; ++nf) S[nf] = dc * S[nf] + fac * T[0][nf];
    nd = dc * nd + fac * ksd;
    m = F63 + mB;
    __syncthreads();
  }
  float* co = p.out + O_PC + ((size_t)(l * 8 + b) * 4 + h) * 4096;
#pragma unroll
  for (int nf = 0; nf < 4; ++nf)
#pragma unroll
    for (int r = 0; r < 4; ++r) co[(size_t)(16 * nf + 4 * l4 + r) * 64 + ecol] = S[nf][r];
  if (w == 0) {
    p.out[O_PN + ((size_t)(l * 8 + b) * 4 + h) * 64 + lane] = nd;
    if (lane == 0) p.out[O_PM + (size_t)(l * 8 + b) * 4 + h] = m;
  }
}

__device__ void k1_phase(const Params& p, int l, char* smem) {
  for (int u = obid(); u < 2048; u += ogdim()) { if (u < 1024) gdn_k1(p, l, u, smem); else ml_k1(p, l, u - 1024, smem); }
}

__device__ void scan_task(const Params& p, int l, int task, char* smem) {
  if (task < 64) gdn_k2(p, l, task, smem);
  else if (task < 96) ml_k2(p, l, task - 64, smem);
  else if (task < 608) gdn_block<8>(p, l, 1, task - 96, smem);
  else ml_block<2>(p, l, 1, task - 608, smem);
}
__device__ void scan_phase(const Params& p, int l, char* smem) {
  const int bid = obid(), nb = ogdim();
  if (nb >= 256) {
    if (bid < 96) scan_task(p, l, bid, smem);
    else for (int task = 96 + (bid - 96); task < 1120; task += nb - 96) scan_task(p, l, task, smem);
  } else {
    for (int task = bid; task < 1120; task += nb) scan_task(p, l, task, smem);
  }
}

__device__ void e2_phase(const Params& p, int l) {
  bf16_t* proj = (bf16_t*)(p.ws + WS_PROJ);
  const float* gnw = p.in[14] + l * 128;
  const float* mnw = p.in[17] + l * 256;
  const int lane = otid() & 63;
  const int gw = obid() * 4 + (otid() >> 6), nw = ogdim() * 4;
  const float2 gw2 = *(const float2*)(gnw + lane * 2);
  const float4 mw4 = *(const float4*)(mnw + lane * 4);
  for (int tok = gw; tok < NTOK; tok += 2 * nw) {
    const int tok2 = (tok + nw < NTOK) ? tok + nw : tok;
    bf16_t* rows[2] = {proj + (size_t)tok * DINS, proj + (size_t)tok2 * DINS};
    unsigned uo[2][4], uz[2][4]; uint2 uh[2], ug[2];
#pragma unroll
    for (int rr = 0; rr < 2; ++rr) {
#pragma unroll
      for (int h = 0; h < 4; ++h) {
        uo[rr][h] = *(const unsigned*)(rows[rr] + 768 + h * 128 + lane * 2);
        uz[rr][h] = *(const unsigned*)(rows[rr] + 2304 + h * 128 + lane * 2);
      }
      uh[rr] = *(const uint2*)(rows[rr] + 1280 + lane * 4);
      ug[rr] = *(const uint2*)(rows[rr] + 3592 + lane * 4);
    }
#pragma unroll
    for (int rr = 0; rr < 2; ++rr) {
      if (rr == 1 && tok2 == tok) continue;
      bf16_t* row = rows[rr];
#pragma unroll
      for (int h = 0; h < 4; ++h) {
        const float o0 = lo16(uo[rr][h]), o1 = hi16(uo[rr][h]);
        const float ss = wsum_dpp(o0 * o0 + o1 * o1);
        const float r = rsqrtf(ss * (1.f / 128.f) + 1e-6f);
        const float y0 = o0 * r * gw2.x * siluf_(lo16(uz[rr][h]));
        const float y1 = o1 * r * gw2.y * siluf_(hi16(uz[rr][h]));
        *(unsigned*)(row + 768 + h * 128 + lane * 2) = pack2(y0, y1);
      }
      {
        float h0 = lo16(uh[rr].x) * sigmoidf_(lo16(ug[rr].x));
        float h1 = hi16(uh[rr].x) * sigmoidf_(hi16(ug[rr].x));
        float h2 = lo16(uh[rr].y) * sigmoidf_(lo16(ug[rr].y));
        float h3 = hi16(uh[rr].y) * sigmoidf_(hi16(ug[rr].y));
        float s = h0 + h1 + h2 + h3;
        s += __int_as_float(__builtin_amdgcn_update_dpp(0, __float_as_int(s), 0xB1, 0xf, 0xf, false));
        s += __int_as_float(__builtin_amdgcn_update_dpp(0, __float_as_int(s), 0x4E, 0xf, 0xf, false));
        s += __int_as_float(__builtin_amdgcn_update_dpp(0, __float_as_int(s), 0x141, 0xf, 0xf, false));
        s += __int_as_float(__builtin_amdgcn_update_dpp(0, __float_as_int(s), 0x140, 0xf, 0xf, false));
        const float mu = s * (1.f / 64.f);
        h0 -= mu; h1 -= mu; h2 -= mu; h3 -= mu;
        float vv = h0 * h0 + h1 * h1 + h2 * h2 + h3 * h3;
        vv += __int_as_float(__builtin_amdgcn_update_dpp(0, __float_as_int(vv), 0xB1, 0xf, 0xf, false));
        vv += __int_as_float(__builtin_amdgcn_update_dpp(0, __float_as_int(vv), 0x4E, 0xf, 0xf, false));
        vv += __int_as_float(__builtin_amdgcn_update_dpp(0, __float_as_int(vv), 0x141, 0xf, 0xf, false));
        vv += __int_as_float(__builtin_amdgcn_update_dpp(0, __float_as_int(vv), 0x140, 0xf, 0xf, false));
        const float r = rsqrtf(vv * (1.f / 64.f) + 1e-5f);
        *(uint2*)(row + 1280 + lane * 4) = make_uint2(pack2(h0 * r * mw4.x, h1 * r * mw4.y), pack2(h2 * r * mw4.z, h3 * r * mw4.w));
      }
    }
  }
}

__device__ void ln_phase(const Params& p, const float* g, const float* b, int final_out) {
  float* pre = p.out + O_Y;
  bf16_t* xb = (bf16_t*)(p.ws + WS_XB);
  const int lane = otid() & 63;
  const int gw = obid() * 4 + (otid() >> 6), nw = ogdim() * 4;
  float4 gg[4], bb[4];
#pragma unroll
  for (int i = 0; i < 4; ++i) { gg[i] = *(const float4*)(g + i * 256 + lane * 4); bb[i] = *(const float4*)(b + i * 256 + lane * 4); }
  for (int tok = gw; tok < NTOK; tok += 2 * nw) {
    const int tok2 = (tok + nw < NTOK) ? tok + nw : tok;
    float* row[2] = {pre + (size_t)tok * 1024, pre + (size_t)tok2 * 1024};
    float4 v[2][4];
#pragma unroll
    for (int rr = 0; rr < 2; ++rr)
#pragma unroll
      for (int i = 0; i < 4; ++i) v[rr][i] = *(const float4*)(row[rr] + i * 256 + lane * 4);
#pragma unroll
    for (int rr = 0; rr < 2; ++rr) {
      float s = 0.f;
#pragma unroll
      for (int i = 0; i < 4; ++i) s += v[rr][i].x + v[rr][i].y + v[rr][i].z + v[rr][i].w;
      const float mu = wsum_dpp(s) * (1.f / 1024.f);
      float q = 0.f;
#pragma unroll
      for (int i = 0; i < 4; ++i) {
        v[rr][i].x -= mu; v[rr][i].y -= mu; v[rr][i].z -= mu; v[rr][i].w -= mu;
        q += v[rr][i].x * v[rr][i].x + v[rr][i].y * v[rr][i].y + v[rr][i].z * v[rr][i].z + v[rr][i].w * v[rr][i].w;
      }
      const float r = rsqrtf(wsum_dpp(q) * (1.f / 1024.f) + 1e-5f);
      const int tk = rr ? tok2 : tok;
      if (rr == 1 && tok2 == tok) continue;
#pragma unroll
      for (int i = 0; i < 4; ++i) {
        const int c = i * 256 + lane * 4;
        float4 y;
        y.x = v[rr][i].x * r * gg[i].x + bb[i].x; y.y = v[rr][i].y * r * gg[i].y + bb[i].y;
        y.z = v[rr][i].z * r * gg[i].z + bb[i].z; y.w = v[rr][i].w * r * gg[i].w + bb[i].w;
        if (final_out) stnt4(row[rr] + c, y);
        else *(uint2*)(xb + (size_t)tk * 1024 + c) = make_uint2(pack2(y.x, y.y), pack2(y.z, y.w));
      }
    }
  }
}

__device__ void e3_phase(const Params& p, int l) {
  bf16_t* hb = (bf16_t*)(p.ws + WS_H);
  const bf16_t* sbb = (const bf16_t*)(p.ws + WS_SB);
  const float* cw = p.in[22] + (size_t)l * 3 * DFF;
  const int total = 120 * 2 * 352;
  for (int idx = obid() * 256 + otid(); idx < total; idx += ogdim() * 256) {
    const int fg = idx % 352, rr = (idx / 352) & 1, ti = idx / 704;
    const int mt = (ti / 15) * 16 + (ti % 15) + 1;
    const int f0 = fg * 8, m = mt * 128 + rr;
    const bf16_t* cur = sbb + (size_t)mt * 8 * DFF;
    const bf16_t* prv = sbb + (size_t)(mt - 1) * 8 * DFF;
    const u32x4 ug0 = *(const u32x4*)(cur + (size_t)(rr * 2) * DFF + f0);
    const u32x4 uv = *(const u32x4*)(cur + (size_t)(rr * 2 + 1) * DFF + f0);
    const u32x4 ug1 = rr ? *(const u32x4*)(cur + f0) : *(const u32x4*)(prv + (size_t)(3 * 2) * DFF + f0);
    const u32x4 ug2 = rr ? *(const u32x4*)(prv + (size_t)(3 * 2) * DFF + f0) : *(const u32x4*)(prv + (size_t)(2 * 2) * DFF + f0);
    float w0[8], w1[8], w2[8];
    *(float4*)w0 = *(const float4*)(cw + f0); *(float4*)(w0 + 4) = *(const float4*)(cw + f0 + 4);
    *(float4*)w1 = *(const float4*)(cw + DFF + f0); *(float4*)(w1 + 4) = *(const float4*)(cw + DFF + f0 + 4);
    *(float4*)w2 = *(const float4*)(cw + 2 * DFF + f0); *(float4*)(w2 + 4) = *(const float4*)(cw + 2 * DFF + f0 + 4);
    u32x4 o;
#pragma unroll
    for (int y = 0; y < 4; ++y) {
      const float ha = siluf_(w0[2 * y] * lo16(ug2[y]) + w1[2 * y] * lo16(ug1[y]) + w2[2 * y] * lo16(ug0[y])) * lo16(uv[y]);
      const float hbv = siluf_(w0[2 * y + 1] * hi16(ug2[y]) + w1[2 * y + 1] * hi16(ug1[y]) + w2[2 * y + 1] * hi16(ug0[y])) * hi16(uv[y]);
      o[y] = pack2(ha, hbv);
    }
    *(u32x4*)(hb + (size_t)m * DFF + f0) = o;
  }
}


#define XB_TMO      128
#define XB_XCNT(j)  (256  + 64 * (j))
#define XB_XSUB(j)  (1280 + 64 * (j))
#define XB_XGEN(j)  (2304 + 64 * (j))
#define XB_TOP      3328
#define XB_TOPGEN   3392
#define XCD_BAR_WORDS 3456
#define XB_SPIN_CAP (1u << 18)
__device__ __forceinline__ unsigned xb_ld(unsigned* p)              { return __hip_atomic_load(p, __ATOMIC_RELAXED, __HIP_MEMORY_SCOPE_AGENT); }
__device__ __forceinline__ unsigned xb_add(unsigned* p, unsigned v) { return __hip_atomic_fetch_add(p, v, __ATOMIC_RELAXED, __HIP_MEMORY_SCOPE_AGENT); }
__device__ __forceinline__ unsigned xb_xcc_id() { return (unsigned)__builtin_amdgcn_s_getreg((3 << 11) | 20) & 0xFu; }
#define XB_SPIN(cond, bar) do { unsigned _sp = 0; while (cond) { __builtin_amdgcn_s_sleep(1); \
    if ((++_sp & 255u) == 0u) { if (xb_ld(&(bar)[XB_TMO])) break; if (_sp > XB_SPIN_CAP) { atomicAdd(&(bar)[XB_TMO], 1u); break; } } } } while (0)
struct XcdBarrier { unsigned* bar; unsigned x; volatile LAS unsigned* st; };
__device__ __forceinline__ XcdBarrier xcd_barrier_post(unsigned* bar, volatile LAS unsigned* st) {
  XcdBarrier b; b.bar = bar; b.x = xb_xcc_id(); b.st = st;
  if (threadIdx.x == 0) (void)xb_add(&bar[XB_XCNT(b.x)], 1u);
  return b;
}
__device__ __forceinline__ void xcd_barrier_complete(unsigned* bar, unsigned x, unsigned& nloc, unsigned& nx) {
  const unsigned G = gridDim.x * gridDim.y * gridDim.z;
  unsigned sum, cnt, mine, sp = 0u;
  for (;;) {
    sum = 0u; cnt = 0u; mine = 0u;
#pragma unroll
    for (unsigned j = 0; j < 16; ++j) { const unsigned c = xb_ld(&bar[XB_XCNT(j)]); sum += c; cnt += (c > 0u) ? 1u : 0u; mine = (j == x) ? c : mine; }
    if (sum == G) break;
    __builtin_amdgcn_s_sleep(1);
    if ((++sp & 255u) == 0u) { if (xb_ld(&bar[XB_TMO])) break; if (sp > XB_SPIN_CAP) { atomicAdd(&bar[XB_TMO], 1u); break; } }
  }
  nloc = mine > 0u ? mine : 1u; nx = cnt > 0u ? cnt : 1u;
}
__device__ __forceinline__ void xcd_barrier(const XcdBarrier& b) {
  asm volatile("s_waitcnt vmcnt(0)" ::: "memory");
  __syncthreads();
  if (threadIdx.x == 0) {
    unsigned* bar = b.bar;
    __builtin_amdgcn_s_waitcnt(0);
    unsigned nloc = b.st[0], nx = b.st[1];
    if (nloc == 0u) { xcd_barrier_complete(bar, b.x, nloc, nx); b.st[0] = nloc; b.st[1] = nx; }
    const unsigned old = xb_add(&bar[XB_XSUB(b.x)], 1u);
    const unsigned gen = old / nloc;
    if (old + 1u == (gen + 1u) * nloc) {
      __builtin_amdgcn_fence(__ATOMIC_RELEASE, "agent");
      asm volatile("s_waitcnt vmcnt(0)" ::: "memory");
      const unsigned og = xb_add(&bar[XB_TOP], 1u);
      const unsigned tg = og / nx;
      if (og + 1u == (tg + 1u) * nx) xb_add(&bar[XB_TOPGEN], 1u);
      else XB_SPIN(xb_ld(&bar[XB_TOPGEN]) == tg, bar);
      __builtin_amdgcn_fence(__ATOMIC_ACQUIRE, "agent");
      xb_add(&bar[XB_XGEN(b.x)], 1u);
      asm volatile("s_waitcnt vmcnt(0)" ::: "memory");
    } else {
      XB_SPIN(xb_ld(&bar[XB_XGEN(b.x)]) == gen, bar);
      __builtin_amdgcn_fence(__ATOMIC_ACQUIRE, "agent");
      asm volatile("s_waitcnt vmcnt(0)" ::: "memory");
    }
  }
  __syncthreads();
}

__global__ void __launch_bounds__(256, 2) fwd_megakernel(Params p, int ph_lo, int ph_hi) {
  extern __shared__ __attribute__((aligned(16))) char smem[];
  cg::grid_group grid = cg::this_grid();
  volatile LAS unsigned* st = (volatile LAS unsigned*)(smem + 69632);
  if (threadIdx.x == 0) { st[0] = 0u; st[1] = 0u; st[2] = 0u; st[3] = 0u; }
  __syncthreads();
  XcdBarrier xb = xcd_barrier_post((unsigned*)(p.ws + WS_BAR), st);
  for (int ph = ph_lo; ph < ph_hi; ++ph) {
    if (ph > ph_lo) {
      if (ph_hi > 1000) grid.sync();
      else xcd_barrier(xb);
    }
    if (ph == 0) { convert_x(p); convert_weights(p, 0, smem); continue; }
    const int l = (ph - 1) / 11, s = (ph - 1) % 11;
    switch (s) {
      case 0: gemm_phase<1>(p, l, smem); break;
      case 1: e1_phase(p, l); break;
      case 2: k1_phase(p, l, smem); break;
      case 3: scan_phase(p, l, smem); break;
      case 4: e2_phase(p, l); break;
      case 5: gemm_phase<2>(p, l, smem); break;
      case 6: ln_phase(p, p.in[19] + l * 1024, p.in[20] + l * 1024, 0); break;
      case 7: gemm_phase<3>(p, l, smem); break;
      case 8: e3_phase(p, l); break;
      case 9: gemm_phase<4>(p, l, smem); break;
      case 10:
        ln_phase(p, p.in[24] + l * 1024, p.in[25] + l * 1024, l == 1);
        if (l == 0) convert_weights(p, 1, smem);
        break;
    }
  }
}

extern "C" void kernel_launch(void* const* d_in, const int* in_sizes, int n_in, void* d_out, int out_size,
                              void* d_ws, size_t ws_size, hipStream_t stream) {
  static int grid_blocks = 0;
  if (!grid_blocks) {
    int dev = 0, cus = 0, per_cu = 0;
    hipGetDevice(&dev);
    hipDeviceGetAttribute(&cus, hipDeviceAttributeMultiprocessorCount, dev);
    hipFuncSetAttribute((const void*)fwd_megakernel, hipFuncAttributeMaxDynamicSharedMemorySize, DYN_LDS);
    hipOccupancyMaxActiveBlocksPerMultiprocessor(&per_cu, fwd_megakernel, 256, DYN_LDS);
    if (per_cu > 2) per_cu = 2;
    if (per_cu < 1) per_cu = 1;
    grid_blocks = cus * per_cu;
  }
  Params p{};
  for (int i = 0; i < 26; ++i) p.in[i] = (const float*)d_in[i];
  p.out = (float*)d_out;
  p.ws = (char*)d_ws;
  int lo = 0, hi = 23;
  hipMemsetAsync((char*)d_ws + WS_BAR, 0, 16384, stream);
  void* args[] = {&p, &lo, &hi};
  hipError_t e = hipLaunchCooperativeKernel((void*)fwd_megakernel, dim3(grid_blocks), dim3(256), args, DYN_LDS, stream);
  if (e != hipSuccess) fprintf(stderr, "cooperative launch failed: %s (grid %d)\n", hipGetErrorString(e), grid_blocks);
}
```
